# Optimizing an MI355X kernel written in HIP

```python
import jax, jax.numpy as jnp
from jax import lax
import numpy as np

D_MODEL = 2048
BATCH = 4
SEQ = 4096
DEPTH = 4

BRANCH_WIDTH = D_MODEL // 2
N_BRANCHES = 3
RET_HEADS = 4
RET_WIDTH = BRANCH_WIDTH
RET_HEAD_DIM = RET_WIDTH // RET_HEADS
RET_CHUNK = 128
RET_ROPE_BASE = 10000.0
POOL_WINDOWS = (2, 4, 8, 16)
POOL_GROUPS = len(POOL_WINDOWS)
POOL_WIDTH = BRANCH_WIDTH
POOL_GROUP_DIM = POOL_WIDTH // POOL_GROUPS
ATT_HEAD_DIM = 128
ATT_WIDTH = BRANCH_WIDTH
ATT_Q_HEADS = ATT_WIDTH // ATT_HEAD_DIM
ATT_KV_HEADS = ATT_Q_HEADS // 4
ATT_KV_WIDTH = ATT_KV_HEADS * ATT_HEAD_DIM
ATT_WINDOW = 128
ATT_BLOCK = 128
ROPE_THETA = 500000.0
ROPE_DIMS = ATT_HEAD_DIM // 4
RMS_EPS = 1e-6
NEG_BIG = -1e30

IN_SIZES = (RET_WIDTH, RET_WIDTH, RET_WIDTH, RET_WIDTH,
            POOL_WIDTH, POOL_WIDTH,
            ATT_WIDTH, ATT_KV_WIDTH, ATT_KV_WIDTH, ATT_WIDTH,
            N_BRANCHES * D_MODEL)
IN_WIDTH = sum(IN_SIZES)

kernel_name = "hybrid_retention_pool_swa_encoder"


def rms_norm(x, gain=None):
    x32 = x.astype(jnp.float32)
    y = x32 * lax.rsqrt(jnp.mean(x32 * x32, axis=-1, keepdims=True) + RMS_EPS)
    if gain is not None:
        y = y * gain.astype(jnp.float32)
    return y.astype(x.dtype)


def rotary(x, inv_freq):
    S = x.shape[1]
    half = inv_freq.shape[0]
    ang = jnp.arange(S, dtype=jnp.float32)[:, None] * inv_freq[None, :]
    cos = jnp.cos(ang)[None, :, None, :]
    sin = jnp.sin(ang)[None, :, None, :]
    xr = x[..., :2 * half].astype(jnp.float32)
    x1, x2 = xr[..., :half], xr[..., half:]
    rot = jnp.concatenate([x1 * cos - x2 * sin, x2 * cos + x1 * sin], axis=-1).astype(x.dtype)
    return jnp.concatenate([rot, x[..., 2 * half:]], axis=-1)


def retention(q, k, v, a_fwd, a_bwd):
    B, S, H, Dh = q.shape
    C = RET_CHUNK
    nC = S // C
    dt = q.dtype
    inv = 1.0 / (RET_ROPE_BASE ** jnp.linspace(0.0, 1.0, Dh // 2, dtype=jnp.float32))
    q = rotary(q, inv)
    k = rotary(k, inv) * jnp.asarray(Dh ** -0.5, dt)
    lg_f = -jnp.exp(a_fwd.astype(jnp.float32))
    lg_b = -jnp.exp(a_bwd.astype(jnp.float32))
    j = jnp.arange(C, dtype=jnp.float32)
    lag = j[:, None] - j[None, :]
    alag = jnp.abs(lag)[None]
    dmask = jnp.where(lag[None] >= 0,
                      jnp.exp(lg_f[:, None, None] * alag),
                      jnp.exp(lg_b[:, None, None] * alag)).astype(dt)
    qc = q.reshape(B, nC, C, H, Dh)
    kc = k.reshape(B, nC, C, H, Dh)
    vc = v.reshape(B, nC, C, H, Dh)
    scores = jnp.einsum('bnjhd,bnlhd->bnhjl', qc, kc) * dmask[None, None]
    out = jnp.einsum('bnhjl,bnlhe->bnjhe', scores, vc)
    w_f = jnp.exp(lg_f[None, :] * (C - 1 - j)[:, None]).astype(dt)
    w_b = jnp.exp(lg_b[None, :] * j[:, None]).astype(dt)
    kv_f = jnp.einsum('bnlhd,lh,bnlhe->nbhde', kc, w_f, vc)
    kv_b = jnp.einsum('bnlhd,lh,bnlhe->nbhde', kc, w_b, vc)
    dec_f = jnp.exp(lg_f * C).astype(dt)[None, :, None, None]
    dec_b = jnp.exp(lg_b * C).astype(dt)[None, :, None, None]

    def step_f(state, kv):
        return state * dec_f + kv, state

    def step_b(state, kv):
        return state * dec_b + kv, state

    init = jnp.zeros((B, H, Dh, Dh), dt)
    _, s_f = lax.scan(step_f, init, kv_f)
    _, s_b = lax.scan(step_b, init, kv_b, reverse=True)
    q_f = jnp.exp(lg_f[None, :] * (j + 1.0)[:, None]).astype(dt)
    q_b = jnp.exp(lg_b[None, :] * (C - j)[:, None]).astype(dt)
    out = (out
           + jnp.einsum('bnjhd,nbhde->bnjhe', qc * q_f[None, None, :, :, None], s_f)
           + jnp.einsum('bnjhd,nbhde->bnjhe', qc * q_b[None, None, :, :, None], s_b))
    out = rms_norm(out.reshape(B, S, H, Dh))
    return out.reshape(B, S, H * Dh)


def multiscale_pool(u, pool_w, pool_scale):
    B, S, _ = u.shape
    ug = u.reshape(B, S, POOL_GROUPS, POOL_GROUP_DIM).astype(jnp.float32)
    cs = jnp.pad(jnp.cumsum(ug, axis=1), ((0, 0), (1, 0), (0, 0), (0, 0)))
    pos = jnp.arange(S)
    groups = []
    for g, w in enumerate(POOL_WINDOWS):
        lo = jnp.clip(pos - w // 2, 0, S)
        hi = jnp.clip(pos + w // 2, 0, S)
        cnt = (hi - lo).astype(jnp.float32)[None, :, None]
        csg = cs[:, :, g]
        mean = (csg[:, hi] - csg[:, lo]) / cnt
        groups.append(mean - ug[:, :, g])
    p = jnp.stack(groups, axis=2).astype(u.dtype)
    y = jnp.einsum('bsgd,gde->bsge', p, pool_w).reshape(B, S, POOL_WIDTH)
    return y * pool_scale


def windowed_gqa(q, k, v, q_gain, k_gain, sink):
    B, S, Hq, Dh = q.shape
    Hkv = k.shape[2]
    G = Hq // Hkv
    nB = S // ATT_BLOCK
    L = ATT_BLOCK
    inv = ROPE_THETA ** (-jnp.arange(ROPE_DIMS // 2, dtype=jnp.float32) / (ROPE_DIMS // 2))
    q = rotary(rms_norm(q, q_gain), inv)
    k = rotary(rms_norm(k, k_gain), inv)
    qb = q.reshape(B, nB, L, Hkv, G, Dh)
    pad = ((0, 0), (1, 1), (0, 0), (0, 0), (0, 0))
    kp = jnp.pad(k.reshape(B, nB, L, Hkv, Dh), pad)
    vp = jnp.pad(v.reshape(B, nB, L, Hkv, Dh), pad)
    kw = jnp.concatenate([kp[:, :-2], kp[:, 1:-1], kp[:, 2:]], axis=2)
    vw = jnp.concatenate([vp[:, :-2], vp[:, 1:-1], vp[:, 2:]], axis=2)
    s = jnp.einsum('bnqkgd,bnskd->bnkgqs', qb, kw).astype(jnp.float32) * (Dh ** -0.5)
    blk = jnp.arange(nB)[:, None]
    qpos = blk * L + jnp.arange(L)[None, :]
    kpos = (blk - 1) * L + jnp.arange(3 * L)[None, :]
    diff = kpos[:, None, :] - qpos[:, :, None]
    valid = ((jnp.abs(diff) <= ATT_WINDOW)
             & (kpos >= 0)[:, None, :] & (kpos < S)[:, None, :])
    s = jnp.where(valid[None, :, None, None], s, NEG_BIG)
    sk = sink.astype(jnp.float32).reshape(Hkv, G)[None, None, :, :, None, None]
    m = jnp.maximum(jnp.max(s, axis=-1, keepdims=True), sk)
    p = jnp.exp(s - m)
    p = p / (jnp.sum(p, axis=-1, keepdims=True) + jnp.exp(sk - m))
    o = jnp.einsum('bnkgqs,bnskd->bnqkgd', p.astype(v.dtype), vw)
    return o.reshape(B, S, Hq * Dh)


def hybrid_layer(x, norm_g, w_in, a_fwd, a_bwd, pool_w, pool_scale,
                 q_gain, k_gain, sink, w_ret, w_pool, w_att, w_out):
    B, S, D = x.shape
    h = rms_norm(x, norm_g)
    z = jnp.einsum('bsd,de->bse', h, w_in)
    (rq, rk, rv, rg, pv, pg, aq, ak, av, ag, mg) = jnp.split(
        z, list(np.cumsum(IN_SIZES)[:-1]), axis=-1)
    ya = retention(rq.reshape(B, S, RET_HEADS, RET_HEAD_DIM),
                   rk.reshape(B, S, RET_HEADS, RET_HEAD_DIM),
                   rv.reshape(B, S, RET_HEADS, RET_HEAD_DIM), a_fwd, a_bwd)
    ya = jnp.einsum('bse,ed->bsd', ya * jax.nn.silu(rg), w_ret)
    yb = multiscale_pool(pv, pool_w, pool_scale)
    yb = jnp.einsum('bse,ed->bsd', yb * jax.nn.silu(pg), w_pool)
    yc = windowed_gqa(aq.reshape(B, S, ATT_Q_HEADS, ATT_HEAD_DIM),
                      ak.reshape(B, S, ATT_KV_HEADS, ATT_HEAD_DIM),
                      av.reshape(B, S, ATT_KV_HEADS, ATT_HEAD_DIM), q_gain, k_gain, sink)
    yc = jnp.einsum('bse,ed->bsd', yc * jax.nn.silu(ag), w_att)
    gates = jax.nn.sigmoid(mg.astype(jnp.float32)).astype(x.dtype).reshape(B, S, N_BRANCHES, D)
    merged = gates[:, :, 0] * ya + gates[:, :, 1] * yb + gates[:, :, 2] * yc
    return x + jnp.einsum('bsd,de->bse', merged, w_out)


def setup_inputs(seed: int = 0) -> dict:
    key = jax.random.key(seed)
    ks = jax.random.split(key, 14)
    f32 = jnp.float32
    D = D_MODEL
    nrm = jax.random.normal
    base = np.log(-np.log1p(-(2.0 ** (-5.0 - np.arange(RET_HEADS))))).astype(np.float32)
    base = jnp.asarray(base)[None, :]
    return {
        "x": nrm(ks[0], (BATCH, SEQ, D), f32),
        "norm_g": 1.0 + 0.02 * nrm(ks[1], (DEPTH, D), f32),
        "w_in": nrm(ks[2], (DEPTH, D, IN_WIDTH), f32) * (D ** -0.5),
        "ret_decay_fwd": base + 0.1 * nrm(ks[3], (DEPTH, RET_HEADS), f32),
        "ret_decay_bwd": base + 0.1 * nrm(ks[4], (DEPTH, RET_HEADS), f32),
        "pool_w": nrm(ks[5], (DEPTH, POOL_GROUPS, POOL_GROUP_DIM, POOL_GROUP_DIM), f32) * (POOL_GROUP_DIM ** -0.5),
        "pool_scale": 1.0 + 0.02 * nrm(ks[6], (DEPTH, POOL_WIDTH), f32),
        "attn_q_gain": 1.0 + 0.02 * nrm(ks[7], (DEPTH, ATT_HEAD_DIM), f32),
        "attn_k_gain": 1.0 + 0.02 * nrm(ks[8], (DEPTH, ATT_HEAD_DIM), f32),
        "attn_sink": 0.5 * nrm(ks[9], (DEPTH, ATT_Q_HEADS), f32),
        "w_ret": nrm(ks[10], (DEPTH, RET_WIDTH, D), f32) * (RET_WIDTH ** -0.5),
        "w_pool": nrm(ks[11], (DEPTH, POOL_WIDTH, D), f32) * (POOL_WIDTH ** -0.5),
        "w_att": nrm(ks[12], (DEPTH, ATT_WIDTH, D), f32) * (ATT_WIDTH ** -0.5),
        "w_out": nrm(ks[13], (DEPTH, D, D), f32) * (D ** -0.5),
    }


def reference(x, norm_g, w_in, ret_decay_fwd, ret_decay_bwd, pool_w, pool_scale,
              attn_q_gain, attn_k_gain, attn_sink, w_ret, w_pool, w_att, w_out):
    for l in range(DEPTH):
        x = hybrid_layer(x, norm_g[l], w_in[l], ret_decay_fwd[l], ret_decay_bwd[l],
                         pool_w[l], pool_scale[l], attn_q_gain[l], attn_k_gain[l],
                         attn_sink[l], w_ret[l], w_pool[l], w_att[l], w_out[l])
    return x
```

```cpp
#include <hip/hip_runtime.h>
#include <hip/hip_cooperative_groups.h>
#include <cstdio>
namespace cg = cooperative_groups;

#ifndef ONE_LAUNCH
#define ONE_LAUNCH 0
#endif

#define LAS __attribute__((address_space(3)))
typedef unsigned short bf16_t;
typedef short bf16x8 __attribute__((ext_vector_type(8)));
typedef float f32x4 __attribute__((ext_vector_type(4)));
typedef unsigned u32x4 __attribute__((ext_vector_type(4)));
typedef unsigned u32x2 __attribute__((ext_vector_type(2)));

constexpr int T_TOK = 16384, DM = 2048, NIN = 14848, SEQ = 4096, DEPTH = 4;
constexpr int C_RQ = 0, C_RK = 1024, C_RV = 2048, C_RG = 3072, C_PV = 4096, C_PG = 5120, C_AQ = 6144, C_AK = 7168, C_AV = 7424, C_AG = 7680, C_MG = 8704;
constexpr int NTHR = 512;
constexpr int LDS_BYTES = 147456;

constexpr size_t SZ_WIN = (size_t)NIN * DM * 2, SZ_WBR = (size_t)DM * 1024 * 2, SZ_WOUT = (size_t)DM * DM * 2, SZ_PW = (size_t)4 * 256 * 256 * 2;
constexpr size_t WS_WIN = 0;
constexpr size_t WS_WRET = WS_WIN + DEPTH * SZ_WIN;
constexpr size_t WS_WPOOL = WS_WRET + DEPTH * SZ_WBR;
constexpr size_t WS_WATT = WS_WPOOL + DEPTH * SZ_WBR;
constexpr size_t WS_WOUT = WS_WATT + DEPTH * SZ_WBR;
constexpr size_t WS_PW = WS_WOUT + DEPTH * SZ_WOUT;
constexpr size_t WS_XB = WS_PW + DEPTH * SZ_PW;
constexpr size_t WS_Z = WS_XB + (size_t)T_TOK * DM * 2;
constexpr size_t WS_ROWSS = WS_Z + (size_t)T_TOK * NIN * 2;
constexpr size_t WS_SF = WS_ROWSS + (size_t)T_TOK * 32 * 4;
constexpr size_t SZ_ST = (size_t)16 * 32 * 65536 * 2;
constexpr size_t WS_SB = WS_SF + SZ_ST;
constexpr size_t WS_YA = WS_SB + SZ_ST;
constexpr size_t SZ_Y = (size_t)T_TOK * 1024 * 2;
constexpr size_t WS_YB = WS_YA + SZ_Y;
constexpr size_t WS_YC = WS_YB + SZ_Y;
constexpr size_t WS_MG = WS_YC + SZ_Y;
constexpr size_t WS_COSR = WS_MG + (size_t)T_TOK * DM * 2;
constexpr size_t WS_SINR = WS_COSR + (size_t)SEQ * 128 * 4;
constexpr size_t WS_COSA = WS_SINR + (size_t)SEQ * 128 * 4;
constexpr size_t WS_SINA = WS_COSA + (size_t)SEQ * 16 * 4;
constexpr size_t WS_END = WS_SINA + (size_t)SEQ * 16 * 4;

struct Args { const float* in[14]; float* out; unsigned char* ws; int ph_lo, ph_hi; };

__device__ __forceinline__ float bf2f(bf16_t b) { return __uint_as_float(((unsigned)b) << 16); }
__device__ __forceinline__ unsigned cvt_pk_bf16(float lo, float hi) { unsigned r; asm volatile("v_cvt_pk_bf16_f32 %0, %1, %2" : "=v"(r) : "v"(lo), "v"(hi)); return r; }
__device__ __forceinline__ bf16_t f2bf(float f) { return (bf16_t)(cvt_pk_bf16(f, 0.f) & 0xffffu); }
__device__ __forceinline__ float wave_sum(float v) {
#pragma unroll
    for (int o = 32; o >= 1; o >>= 1) v += __shfl_xor(v, o);
    return v;
}
__device__ __forceinline__ float wave_max(float v) {
#pragma unroll
    for (int o = 32; o >= 1; o >>= 1) v = fmaxf(v, __shfl_xor(v, o));
    return v;
}
__device__ __forceinline__ int otid() { int t = threadIdx.x; asm volatile("" : "+v"(t)); return t; }
__device__ __forceinline__ float silu_f(float v) { return v / (1.f + __expf(-v)); }
__device__ __forceinline__ float sigm_f(float v) { return 1.f / (1.f + __expf(-v)); }
__device__ __forceinline__ void sincos_red(float ang, float& s, float& c) {
    const double a = (double)ang; const double k = rint(a * 0.15915494309189535); const float r = (float)(a - k * 6.283185307179586);
    s = sinf(r); c = cosf(r);
}

namespace pg8 {
constexpr int BM = 256, BK = 64, HALF = 128, HTB = HALF * BK * 2, STAGE_BYTES = 8 * HTB, NXCD = 8, WGM = 8;
__device__ __forceinline__ int lds_byte(int r, int c) { const int st = (r >> 4) * 2 + (c >> 5), rr = r & 15, cc = c & 31, ob = rr * 64 + cc * 2; return st * 1024 + (ob ^ (((ob >> 9) & 1) << 5)); }
__device__ __forceinline__ void stage_rc(int b, int& R, int& C) { const int st = b / 1024, sb = b % 1024, swz = sb ^ (((sb >> 9) & 1) << 5); R = (st >> 1) * 16 + swz / 64; C = (st & 1) * 32 + (swz % 64) / 2; }
__device__ __forceinline__ int perm32(int rho) { const int n = rho >> 4, i = rho & 15; return 8 * (i >> 2) + 4 * n + (i & 3); }
struct Unit { const char* a; const char* b; int pm, pn, sub; };
__device__ __forceinline__ bool tile_order(long L, int nM, int nN, int& pm, int& pn) {
    const int nwg = nM * nN; if (L >= nwg) return false;
    int wgid = (int)L; { const int q = nwg / NXCD, r = nwg % NXCD, xcd = wgid % NXCD, off = wgid / NXCD; wgid = (xcd < r ? xcd * (q + 1) : r * (q + 1) + (xcd - r) * q) + off; }
    const int nig = WGM * nN, gid = wgid / nig, fm = gid * WGM, gsz = (nM - fm) < WGM ? (nM - fm) : WGM;
    pm = fm + ((wgid % nig) % gsz); pn = (wgid % nig) / gsz; return true;
}
template <class Prog>
__device__ __forceinline__ void gemm_phase(LAS unsigned char* lds, const int K, const Prog& S) {
    int tid_ = threadIdx.x; asm volatile("" : "+v"(tid_));
    const int tid = tid_, wid = __builtin_amdgcn_readfirstlane(tid >> 6), lane = tid & 63, wr = wid >> 2, wc = wid & 3, fr = lane & 15, fq = lane >> 4;
    const int nt = K / BK;
    unsigned voffA[2], voffB[2];
#pragma unroll
    for (int i = 0; i < 2; ++i) { int R, C; stage_rc(tid * 16 + i * 8192, R, C); const int Rb = Prog::PERM ? ((R & ~31) + perm32(R & 31)) : R;
        voffA[i] = (unsigned)(R * K + C) * 2u; voffB[i] = (unsigned)(Rb * K + C) * 2u; }
    const size_t kstep = (size_t)(BK * 2);
    const size_t hstep = (size_t)HALF * K * 2;
    const unsigned ldsw = (unsigned)wid * 1024u;
    const int aoff = lds_byte(wr * 64 + fr, fq * 8), boff = lds_byte(wc * 32 + fr, fq * 8);
#define PG8_SA(b, h) (((b) * 2 + (h)) * HTB)
#define PG8_SB(b, h) ((4 + (b) * 2 + (h)) * HTB)
#define PG8_STAGE(bufoff, gbase, voff) do { _Pragma("unroll") for (int _i = 0; _i < 2; ++_i) \
        __builtin_amdgcn_global_load_lds((const unsigned*)((const char*)(gbase) + (voff)[_i]), (LAS unsigned*)(lds + (bufoff) + ldsw + _i * 8192), 16, 0, 0); } while (0)
#define PG8_LDA(dst, b, h) do { _Pragma("unroll") for (int m = 0; m < 4; ++m) _Pragma("unroll") for (int k = 0; k < 2; ++k) dst[m][k] = *(const LAS bf16x8*)(lds + PG8_SA(b, h) + aoff + m * 2048 + k * 1024); } while (0)
#define PG8_LDB(dst, b, h) do { _Pragma("unroll") for (int n = 0; n < 2; ++n) _Pragma("unroll") for (int k = 0; k < 2; ++k) dst[n][k] = *(const LAS bf16x8*)(lds + PG8_SB(b, h) + boff + n * 2048 + k * 1024); } while (0)
#define PG8_MMA(ai, bj, At, Bt) do { __builtin_amdgcn_s_setprio(1); _Pragma("unroll") for (int m = 0; m < 4; ++m) _Pragma("unroll") for (int n = 0; n < 2; ++n) _Pragma("unroll") for (int k = 0; k < 2; ++k) \
        acc[ai][bj][m][n] = __builtin_amdgcn_mfma_f32_16x16x32_bf16(Bt[n][k], At[m][k], acc[ai][bj][m][n], 0, 0, 0); __builtin_amdgcn_s_setprio(0); } while (0)
#define PG8_WAIT_V(n) asm volatile("s_waitcnt vmcnt(" #n ")" ::: "memory")
#define PG8_WAIT_L(n) asm volatile("s_waitcnt lgkmcnt(" #n ")" ::: "memory")
#define PG8_BAR __builtin_amdgcn_s_barrier()
#define PG8_SCHED __builtin_amdgcn_sched_barrier(0)
    Unit cur, nxt; int ui = 0;
    if (!S.next(0, cur)) return;
    f32x4 acc[2][2][4][2];
#pragma unroll
    for (int a = 0; a < 2; ++a)
#pragma unroll
        for (int b = 0; b < 2; ++b)
#pragma unroll
            for (int m = 0; m < 4; ++m)
#pragma unroll
                for (int n = 0; n < 2; ++n) acc[a][b][m][n] = (f32x4){0.f, 0.f, 0.f, 0.f};
    bf16x8 At[4][2], B0[2][2], B1[2][2];
    const char* cA = cur.a; const char* cB = cur.b;
    PG8_STAGE(PG8_SB(0, 0), cB, voffB); PG8_STAGE(PG8_SA(0, 0), cA, voffA); PG8_STAGE(PG8_SB(0, 1), cB + hstep, voffB); PG8_STAGE(PG8_SA(0, 1), cA + hstep, voffA);
    if (wr == 1) PG8_BAR;
    PG8_WAIT_V(4); PG8_BAR;
    PG8_STAGE(PG8_SB(1, 0), cB + kstep, voffB); PG8_STAGE(PG8_SA(1, 0), cA + kstep, voffA); PG8_STAGE(PG8_SB(1, 1), cB + hstep + kstep, voffB);
    PG8_WAIT_V(6); PG8_BAR;
    for (;;) {
        const bool has_next = S.next(ui + 1, nxt);
        const char* nA = has_next ? nxt.a : cA; const char* nB = has_next ? nxt.b : cB;
        for (int t = 0; t < nt; t += 2) {
            const bool last = (t == nt - 2);
            const char* a1 = cA + (size_t)(t + 1) * kstep;
            const char* a2 = last ? nA : cA + (size_t)(t + 2) * kstep; const char* b2 = last ? nB : cB + (size_t)(t + 2) * kstep;
            const char* a3 = a2 + kstep; const char* b3 = b2 + kstep;
            PG8_LDB(B0, 0, 0); PG8_SCHED; PG8_LDA(At, 0, 0); PG8_STAGE(PG8_SA(1, 1), a1 + hstep, voffA);
            PG8_WAIT_L(8); PG8_BAR; PG8_WAIT_L(0); PG8_MMA(0, 0, At, B0); PG8_BAR; PG8_SCHED;
            PG8_LDB(B1, 0, 1); PG8_STAGE(PG8_SB(0, 0), b2, voffB);
            PG8_BAR; PG8_WAIT_L(0); PG8_MMA(0, 1, At, B1); PG8_BAR;
            PG8_LDA(At, 0, 1); PG8_STAGE(PG8_SA(0, 0), a2, voffA);
            PG8_BAR; PG8_WAIT_L(0); PG8_MMA(1, 0, At, B0); PG8_BAR; PG8_SCHED;
            PG8_STAGE(PG8_SB(0, 1), b2 + hstep, voffB);
            PG8_WAIT_V(6); PG8_BAR; PG8_MMA(1, 1, At, B1); PG8_BAR;
            PG8_LDB(B0, 1, 0); PG8_SCHED; PG8_LDA(At, 1, 0); PG8_STAGE(PG8_SA(0, 1), a2 + hstep, voffA);
            PG8_WAIT_L(8); PG8_BAR; PG8_WAIT_L(0); PG8_MMA(0, 0, At, B0); PG8_BAR; PG8_SCHED;
            PG8_LDB(B1, 1, 1); PG8_STAGE(PG8_SB(1, 0), b3, voffB);
            PG8_BAR; PG8_WAIT_L(0); PG8_MMA(0, 1, At, B1); PG8_BAR;
            PG8_LDA(At, 1, 1); PG8_STAGE(PG8_SA(1, 0), a3, voffA);
            PG8_BAR; PG8_WAIT_L(0); PG8_MMA(1, 0, At, B0); PG8_BAR; PG8_SCHED;
            PG8_STAGE(PG8_SB(1, 1), b3 + hstep, voffB);
            PG8_WAIT_V(6); PG8_BAR; PG8_MMA(1, 1, At, B1); PG8_BAR;
        }
        S.epi(acc, cur, wr, wc, fr, fq);
        if (!S.keep(cur)) {
#pragma unroll
            for (int a = 0; a < 2; ++a)
#pragma unroll
                for (int b = 0; b < 2; ++b)
#pragma unroll
                    for (int m = 0; m < 4; ++m)
#pragma unroll
                        for (int n = 0; n < 2; ++n) acc[a][b][m][n] = (f32x4){0.f, 0.f, 0.f, 0.f};
        }
        if (!has_next) break;
        cur = nxt; cA = nA; cB = nB; ++ui;
    }
    PG8_WAIT_V(0);
    if (wr == 0) PG8_BAR;
    PG8_BAR;
#undef PG8_SA
#undef PG8_SB
#undef PG8_STAGE
#undef PG8_LDA
#undef PG8_LDB
#undef PG8_MMA
#undef PG8_WAIT_V
#undef PG8_WAIT_L
#undef PG8_BAR
#undef PG8_SCHED
}
}

struct InProj {
    static constexpr bool PERM = true;
    const bf16_t* A; const bf16_t* Bt; bf16_t* Z; const float* rowss; const float* cosR; const float* sinR; int G, c;
    __device__ __forceinline__ bool next(int i, pg8::Unit& u) const {
        if (!pg8::tile_order((long)i * G + c, T_TOK / 256, NIN / 256, u.pm, u.pn)) return false;
        u.a = (const char*)(A + (size_t)u.pm * 256 * DM); u.b = (const char*)(Bt + (size_t)u.pn * 256 * DM); u.sub = 0; return true;
    }
    __device__ __forceinline__ bool keep(const pg8::Unit&) const { return false; }
    __device__ __forceinline__ void epi(f32x4 (&acc)[2][2][4][2], const pg8::Unit& u, int wr, int wc, int fr, int fq) const {
        const int row0 = u.pm * 256 + wr * 64 + fr, col0 = u.pn * 256 + wc * 32 + 8 * fq;
        const int pn = u.pn;
        const int mode = (pn < 8) ? 1 : ((pn >= 12 && pn < 16) || (pn >= 20 && pn < 24) || (pn >= 30 && pn < 34)) ? 2 : (pn >= 34 ? 3 : 0);
        const float ksc = (pn >= 4 && pn < 8) ? 0.0625f : 1.0f;
#pragma unroll
        for (int ai = 0; ai < 2; ++ai)
#pragma unroll
            for (int m = 0; m < 4; ++m) {
                const int row = row0 + ai * 128 + m * 16;
                float rsum;
                { const f32x4* rp = (const f32x4*)(rowss + (size_t)row * 32); f32x4 t4 = rp[0];
#pragma unroll
                  for (int q = 1; q < 8; ++q) t4 += rp[q];
                  rsum = (t4[0] + t4[1]) + (t4[2] + t4[3]); }
                const float rs = rsqrtf(rsum * (1.0f / DM) + 1e-6f);
                f32x4 v[2][2];
#pragma unroll
                for (int bj = 0; bj < 2; ++bj)
#pragma unroll
                    for (int n = 0; n < 2; ++n) v[bj][n] = acc[ai][bj][m][n] * rs;
                if (mode == 1) {
                    const int pos = row & (SEQ - 1);
#pragma unroll
                    for (int n = 0; n < 2; ++n) {
                        const f32x4 cs = *(const f32x4*)(cosR + pos * 128 + wc * 32 + 8 * fq + 4 * n), sn = *(const f32x4*)(sinR + pos * 128 + wc * 32 + 8 * fq + 4 * n);
                        const f32x4 x1 = v[0][n], x2 = v[1][n];
                        v[0][n] = (x1 * cs - x2 * sn) * ksc; v[1][n] = (x2 * cs + x1 * sn) * ksc;
                    }
                } else if (mode == 2) {
#pragma unroll
                    for (int bj = 0; bj < 2; ++bj)
#pragma unroll
                        for (int n = 0; n < 2; ++n)
#pragma unroll
                            for (int j = 0; j < 4; ++j) v[bj][n][j] = silu_f(v[bj][n][j]);
                } else if (mode == 3) {
#pragma unroll
                    for (int bj = 0; bj < 2; ++bj)
#pragma unroll
                        for (int n = 0; n < 2; ++n)
#pragma unroll
                            for (int j = 0; j < 4; ++j) v[bj][n][j] = sigm_f(v[bj][n][j]);
                }
                bf16_t* rowp = Z + (size_t)row * NIN + col0;
#pragma unroll
                for (int bj = 0; bj < 2; ++bj) {
                    u32x4 w; w.x = cvt_pk_bf16(v[bj][0][0], v[bj][0][1]); w.y = cvt_pk_bf16(v[bj][0][2], v[bj][0][3]); w.z = cvt_pk_bf16(v[bj][1][0], v[bj][1][1]); w.w = cvt_pk_bf16(v[bj][1][2], v[bj][1][3]);
                    *(u32x4*)(rowp + bj * 128) = w;
                }
            }
    }
};

struct MergeP {
    static constexpr bool PERM = true;
    const bf16_t *Y0, *W0; const bf16_t* Z; bf16_t* Mg; int G, c;
    __device__ __forceinline__ bool next(int i, pg8::Unit& u) const {
        const int ti = i / 3; u.sub = i - ti * 3;
        if (!pg8::tile_order((long)ti * G + c, T_TOK / 256, DM / 256, u.pm, u.pn)) return false;
        const bf16_t* yy = Y0 + (size_t)u.sub * (SZ_Y / 2); const bf16_t* ww = W0 + (size_t)u.sub * (DEPTH * SZ_WBR / 2);
        u.a = (const char*)(yy + (size_t)u.pm * 256 * 1024); u.b = (const char*)(ww + (size_t)u.pn * 256 * 1024); return true;
    }
    __device__ __forceinline__ bool keep(const pg8::Unit& u) const { return u.sub < 2; }
    __device__ __forceinline__ void epi(f32x4 (&acc)[2][2][4][2], const pg8::Unit& u, int wr, int wc, int fr, int fq) const {
        const int row0 = u.pm * 256 + wr * 64 + fr, col0 = u.pn * 256 + wc * 32 + 8 * fq;
#pragma unroll
        for (int ai = 0; ai < 2; ++ai)
#pragma unroll
            for (int m = 0; m < 4; ++m) {
                const int row = row0 + ai * 128 + m * 16;
                const bf16_t* gp = Z + (size_t)row * NIN + C_MG + col0;
#pragma unroll
                for (int bj = 0; bj < 2; ++bj) {
                    const u32x4 gn = *(const u32x4*)(gp + u.sub * DM + bj * 128);
                    f32x4 f0, f1;
                    f0[0] = __uint_as_float(gn[0] << 16); f0[1] = __uint_as_float(gn[0] & 0xffff0000u); f0[2] = __uint_as_float(gn[1] << 16); f0[3] = __uint_as_float(gn[1] & 0xffff0000u);
                    f1[0] = __uint_as_float(gn[2] << 16); f1[1] = __uint_as_float(gn[2] & 0xffff0000u); f1[2] = __uint_as_float(gn[3] << 16); f1[3] = __uint_as_float(gn[3] & 0xffff0000u);
                    if (u.sub < 2) {
                        const u32x4 gd = *(const u32x4*)(gp + (u.sub + 1) * DM + bj * 128);
                        f32x4 d0, d1;
                        d0[0] = __uint_as_float(gd[0] << 16); d0[1] = __uint_as_float(gd[0] & 0xffff0000u); d0[2] = __uint_as_float(gd[1] << 16); d0[3] = __uint_as_float(gd[1] & 0xffff0000u);
                        d1[0] = __uint_as_float(gd[2] << 16); d1[1] = __uint_as_float(gd[2] & 0xffff0000u); d1[2] = __uint_as_float(gd[3] << 16); d1[3] = __uint_as_float(gd[3] & 0xffff0000u);
                        f0 = f0 / d0; f1 = f1 / d1;
                    }
                    acc[ai][bj][m][0] *= f0; acc[ai][bj][m][1] *= f1;
                    if (u.sub == 2) {
                        const f32x4 v0 = acc[ai][bj][m][0], v1 = acc[ai][bj][m][1];
                        u32x4 w; w.x = cvt_pk_bf16(v0[0], v0[1]); w.y = cvt_pk_bf16(v0[2], v0[3]); w.z = cvt_pk_bf16(v1[0], v1[1]); w.w = cvt_pk_bf16(v1[2], v1[3]);
                        *(u32x4*)(Mg + (size_t)row * DM + col0 + bj * 128) = w;
                    }
                }
            }
    }
};

struct OutProj {
    static constexpr bool PERM = false;
    const bf16_t* A; const bf16_t* Bt; const float* xin; float* xout; bf16_t* xb; float* rowss_next; int G, c;
    __device__ __forceinline__ bool next(int i, pg8::Unit& u) const {
        if (!pg8::tile_order((long)i * G + c, T_TOK / 256, DM / 256, u.pm, u.pn)) return false;
        u.a = (const char*)(A + (size_t)u.pm * 256 * DM); u.b = (const char*)(Bt + (size_t)u.pn * 256 * DM); u.sub = 0; return true;
    }
    __device__ __forceinline__ bool keep(const pg8::Unit&) const { return false; }
    __device__ __forceinline__ void epi(f32x4 (&acc)[2][2][4][2], const pg8::Unit& u, int wr, int wc, int fr, int fq) const {
        const int row0 = u.pm * 256 + wr * 64 + fr, col0 = u.pn * 256 + wc * 32 + 4 * fq;
#pragma unroll
        for (int ai = 0; ai < 2; ++ai)
#pragma unroll
            for (int m = 0; m < 4; ++m) {
                const int row = row0 + ai * 128 + m * 16;
                const size_t off = (size_t)row * DM + col0;
                float ss = 0.f;
#pragma unroll
                for (int bj = 0; bj < 2; ++bj)
#pragma unroll
                    for (int n = 0; n < 2; ++n) {
                        const f32x4 xo = *(const f32x4*)(xin + off + bj * 128 + n * 16);
                        const f32x4 o = xo + acc[ai][bj][m][n];
                        *(f32x4*)(xout + off + bj * 128 + n * 16) = o;
                        ss += o[0] * o[0] + o[1] * o[1] + o[2] * o[2] + o[3] * o[3];
                        if (rowss_next) { u32x2 w; w.x = cvt_pk_bf16(o[0], o[1]); w.y = cvt_pk_bf16(o[2], o[3]); *(u32x2*)(xb + off + bj * 128 + n * 16) = w; }
                    }
                if (rowss_next) {
                    ss += __shfl_xor(ss, 16); ss += __shfl_xor(ss, 32);
                    if (fq == 0) rowss_next[(size_t)row * 32 + u.pn * 4 + wc] = ss;
                }
            }
    }
};

__device__ void tconv(const float* __restrict__ src, bf16_t* __restrict__ dst, int R, int C, const float* __restrict__ scale, float* tile) {
    const int tid = otid();
    const int ntc = C / 64, nt = (R / 64) * ntc;
    for (int t = blockIdx.x; t < nt; t += gridDim.x) {
        const int tr = t / ntc, tc = t - tr * ntc;
        {
            const int r = tid >> 3, c8 = (tid & 7) * 8;
            const float* sp = src + (size_t)(tr * 64 + r) * C + tc * 64 + c8;
            const float4 v0 = *(const float4*)sp, v1 = *(const float4*)(sp + 4);
            const float sc = scale ? scale[tr * 64 + r] : 1.f;
            float* tp = tile + r * 65 + c8;
            tp[0] = v0.x * sc; tp[1] = v0.y * sc; tp[2] = v0.z * sc; tp[3] = v0.w * sc; tp[4] = v1.x * sc; tp[5] = v1.y * sc; tp[6] = v1.z * sc; tp[7] = v1.w * sc;
        }
        __syncthreads();
        {
            const int c = tid >> 3, r8 = (tid & 7) * 8;
            const float* tp = tile + r8 * 65 + c;
            u32x4 o; o.x = cvt_pk_bf16(tp[0], tp[65]); o.y = cvt_pk_bf16(tp[130], tp[195]); o.z = cvt_pk_bf16(tp[260], tp[325]); o.w = cvt_pk_bf16(tp[390], tp[455]);
            *(u32x4*)(dst + (size_t)(tc * 64 + c) * R + tr * 64 + r8) = o;
        }
        __syncthreads();
    }
}

__device__ void prologue(const Args& a, float* lds) {
    unsigned char* ws = a.ws;
    const int tid = otid(), lane = tid & 63, wave = tid >> 6;
    const size_t gtid = (size_t)blockIdx.x * NTHR + tid, gstr = (size_t)gridDim.x * NTHR;
    {
        const float* x = a.in[0]; bf16_t* xb = (bf16_t*)(ws + WS_XB); float* rowss = (float*)(ws + WS_ROWSS);
        for (int row = blockIdx.x * 8 + wave; row < T_TOK; row += gridDim.x * 8) {
            const float4* xp = (const float4*)(x + (size_t)row * DM); float ss = 0.f;
#pragma unroll
            for (int i = 0; i < 8; ++i) { const float4 v = xp[lane + 64 * i]; ss += v.x * v.x + v.y * v.y + v.z * v.z + v.w * v.w;
                u32x2 o; o.x = cvt_pk_bf16(v.x, v.y); o.y = cvt_pk_bf16(v.z, v.w); *(u32x2*)(xb + (size_t)row * DM + (lane + 64 * i) * 4) = o; }
            ss = wave_sum(ss);
            if (lane < 32) rowss[(size_t)row * 32 + lane] = lane == 0 ? ss : 0.f;
        }
    }
    {
        float* cR = (float*)(ws + WS_COSR); float* sR = (float*)(ws + WS_SINR); float* cA = (float*)(ws + WS_COSA); float* sA = (float*)(ws + WS_SINA);
        for (size_t i = gtid; i < (size_t)SEQ * 128; i += gstr) { const int s = (int)(i >> 7), k = (int)(i & 127);
            const float inv = 1.0f / exp2f((float)k * (1.0f / 127.0f) * 13.287712379549449f); float sn, cs; sincos_red((float)s * inv, sn, cs); cR[i] = cs; sR[i] = sn; }
        for (size_t i = gtid; i < (size_t)SEQ * 16; i += gstr) { const int s = (int)(i >> 4), k = (int)(i & 15);
            const float inv = exp2f(-(float)k * (1.0f / 16.0f) * 18.931568569324174f); float sn, cs; sincos_red((float)s * inv, sn, cs); cA[i] = cs; sA[i] = sn; }
    }
    for (int l = 0; l < DEPTH; ++l) {
        tconv(a.in[2] + (size_t)l * DM * NIN, (bf16_t*)(ws + WS_WIN + l * SZ_WIN), DM, NIN, a.in[1] + l * DM, lds);
        tconv(a.in[10] + (size_t)l * 1024 * DM, (bf16_t*)(ws + WS_WRET + l * SZ_WBR), 1024, DM, nullptr, lds);
        tconv(a.in[11] + (size_t)l * 1024 * DM, (bf16_t*)(ws + WS_WPOOL + l * SZ_WBR), 1024, DM, nullptr, lds);
        tconv(a.in[12] + (size_t)l * 1024 * DM, (bf16_t*)(ws + WS_WATT + l * SZ_WBR), 1024, DM, nullptr, lds);
        tconv(a.in[13] + (size_t)l * DM * DM, (bf16_t*)(ws + WS_WOUT + l * SZ_WOUT), DM, DM, nullptr, lds);
        for (int g = 0; g < 4; ++g) tconv(a.in[5] + ((size_t)l * 4 + g) * 65536, (bf16_t*)(ws + WS_PW + l * SZ_PW) + g * 65536, 256, 256, nullptr, lds);
    }
}

__device__ void ret_scan_naive(const Args& a, int l) {
    const bf16_t* Z = (const bf16_t*)(a.ws + WS_Z);
    const size_t gtid = (size_t)blockIdx.x * NTHR + otid(), gstr = (size_t)gridDim.x * NTHR;
    for (size_t idx = gtid; idx < (size_t)2097152; idx += gstr) {
        const int d = (int)(idx & 255), e = (int)((idx >> 8) & 255), dir = (int)((idx >> 16) & 1), bh = (int)(idx >> 17), b = bh >> 2, h = bh & 3;
        const float lg = -expf(a.in[dir ? 4 : 3][l * 4 + h]);
        const float dec = expf(lg * 128.f);
        bf16_t* ST = (bf16_t*)(a.ws + (dir ? WS_SB : WS_SF));
        float st = 0.f;
        for (int step = 0; step < 32; ++step) {
            const int n = dir ? 31 - step : step;
            ST[(((size_t)bh * 32 + n) * 256 + e) * 256 + d] = f2bf(st);
            float kv = 0.f;
            const bf16_t* zp = Z + (size_t)(b * SEQ + n * 128) * NIN + h * 256;
            for (int j = 0; j < 128; ++j) {
                const float w = dir ? expf(lg * (float)j) : expf(lg * (float)(127 - j));
                kv += bf2f(zp[(size_t)j * NIN + C_RK + d]) * w * bf2f(zp[(size_t)j * NIN + C_RV + e]);
            }
            st = st * dec + kv;
        }
    }
}

__device__ void ret_out_naive(const Args& a, int l, float* P) {
    const bf16_t* Z = (const bf16_t*)(a.ws + WS_Z); bf16_t* Ya = (bf16_t*)(a.ws + WS_YA);
    const bf16_t* SF = (const bf16_t*)(a.ws + WS_SF); const bf16_t* SB = (const bf16_t*)(a.ws + WS_SB);
    const int tid = otid();
    for (int item = blockIdx.x; item < 512; item += gridDim.x) {
        const int b = item >> 7, n = (item >> 2) & 31, h = item & 3, bh = b * 4 + h;
        const int t0 = b * SEQ + n * 128;
        const float lgf = -expf(a.in[3][l * 4 + h]), lgb = -expf(a.in[4][l * 4 + h]);
        for (int p = tid; p < 16384; p += NTHR) {
            const int j = p >> 7, k = p & 127;
            const bf16_t* qp = Z + (size_t)(t0 + j) * NIN + C_RQ + h * 256; const bf16_t* kp = Z + (size_t)(t0 + k) * NIN + C_RK + h * 256;
            float dot = 0.f;
            for (int d = 0; d < 256; ++d) dot += bf2f(qp[d]) * bf2f(kp[d]);
            const int lag = j - k;
            P[p] = dot * (lag >= 0 ? expf(lgf * (float)lag) : expf(lgb * (float)(-lag)));
        }
        __syncthreads();
        for (int pass = 0; pass < 4; ++pass) {
            const int j = pass * 32 + (tid >> 4), eg = tid & 15;
            float o[16];
#pragma unroll
            for (int i = 0; i < 16; ++i) o[i] = 0.f;
            for (int k = 0; k < 128; ++k) {
                const float pv = P[j * 128 + k];
                const bf16_t* vp = Z + (size_t)(t0 + k) * NIN + C_RV + h * 256 + eg * 16;
#pragma unroll
                for (int i = 0; i < 16; ++i) o[i] += pv * bf2f(vp[i]);
            }
            const bf16_t* qp = Z + (size_t)(t0 + j) * NIN + C_RQ + h * 256;
            const float qf = expf(lgf * (float)(j + 1)), qb = expf(lgb * (float)(128 - j));
#pragma unroll
            for (int i = 0; i < 16; ++i) {
                const size_t so = (((size_t)bh * 32 + n) * 256 + eg * 16 + i) * 256;
                float cf = 0.f, cb = 0.f;
                for (int d = 0; d < 256; ++d) { const float qv = bf2f(qp[d]); cf += qv * bf2f(SF[so + d]); cb += qv * bf2f(SB[so + d]); }
                o[i] += qf * cf + qb * cb;
            }
            float ss = 0.f;
#pragma unroll
            for (int i = 0; i < 16; ++i) ss += o[i] * o[i];
            ss += __shfl_xor(ss, 1); ss += __shfl_xor(ss, 2); ss += __shfl_xor(ss, 4); ss += __shfl_xor(ss, 8);
            const float rs = rsqrtf(ss * (1.0f / 256.0f) + 1e-6f);
            const bf16_t* gp = Z + (size_t)(t0 + j) * NIN + C_RG + h * 256 + eg * 16;
            bf16_t* yp = Ya + (size_t)(t0 + j) * 1024 + h * 256 + eg * 16;
#pragma unroll
            for (int i = 0; i < 16; ++i) yp[i] = f2bf(o[i] * rs * bf2f(gp[i]));
        }
        __syncthreads();
    }
}

__device__ void attn_naive(const Args& a, int l, float* lds) {
    const bf16_t* Z = (const bf16_t*)(a.ws + WS_Z); bf16_t* Yc = (bf16_t*)(a.ws + WS_YC);
    const float* cA = (const float*)(a.ws + WS_COSA); const float* sA = (const float*)(a.ws + WS_SINA);
    const float* qg = a.in[7] + l * 128; const float* kg = a.in[8] + l * 128; const float* sink = a.in[9] + l * 8;
    float* qs = lds; float* ps = lds + 8 * 128;
    const int tid = otid(), lane = tid & 63, wave = tid >> 6;
    for (int w0 = blockIdx.x * 8; w0 < T_TOK * 8; w0 += gridDim.x * 8) {
        const int qi = w0 + wave, t = qi >> 3, hq = qi & 7, kvh = hq >> 2, pos = t & (SEQ - 1), b = t >> 12;
        const bf16_t* qp = Z + (size_t)t * NIN + C_AQ + hq * 128;
        {
            const float x0 = bf2f(qp[lane]), x1 = bf2f(qp[lane + 64]);
            const float ss = wave_sum(x0 * x0 + x1 * x1); const float rs = rsqrtf(ss * (1.0f / 128.0f) + 1e-6f);
            qs[wave * 128 + lane] = x0 * rs * qg[lane]; qs[wave * 128 + lane + 64] = x1 * rs * qg[lane + 64];
        }
        __syncthreads();
        float rot = 0.f;
        if (lane < 32) { const int i = lane & 15; const float xa = qs[wave * 128 + i], xb = qs[wave * 128 + i + 16], c = cA[pos * 16 + i], s = sA[pos * 16 + i]; rot = lane < 16 ? xa * c - xb * s : xb * c + xa * s; }
        __syncthreads();
        if (lane < 32) qs[wave * 128 + lane] = rot;
        __syncthreads();
        float sc[5]; const float skv = sink[hq]; float mx = skv;
#pragma unroll
        for (int r = 0; r < 5; ++r) {
            const int jrel = lane + 64 * r, kp = pos - 128 + jrel; const bool valid = (jrel <= 256) && (kp >= 0) && (kp < SEQ);
            float s = -1e30f;
            if (valid) {
                const bf16_t* kr = Z + (size_t)(b * SEQ + kp) * NIN + C_AK + kvh * 128;
                float kss = 0.f;
                for (int d = 0; d < 128; ++d) { const float kv = bf2f(kr[d]); kss += kv * kv; }
                const float rsk = rsqrtf(kss * (1.0f / 128.0f) + 1e-6f);
                float dot = 0.f;
                for (int i = 0; i < 16; ++i) { const float xa = bf2f(kr[i]) * kg[i], xb = bf2f(kr[i + 16]) * kg[i + 16], c = cA[kp * 16 + i], sn = sA[kp * 16 + i];
                    dot += (xa * c - xb * sn) * qs[wave * 128 + i] + (xb * c + xa * sn) * qs[wave * 128 + i + 16]; }
                for (int d = 32; d < 128; ++d) dot += bf2f(kr[d]) * kg[d] * qs[wave * 128 + d];
                s = dot * rsk * 0.08838834764831845f;
            }
            sc[r] = s; mx = fmaxf(mx, s);
        }
        mx = wave_max(mx);
        float sum = 0.f;
#pragma unroll
        for (int r = 0; r < 5; ++r) { const float p = __expf(sc[r] - mx); sc[r] = p; sum += p; }
        sum = wave_sum(sum) + __expf(skv - mx);
        const float isum = 1.0f / sum;
#pragma unroll
        for (int r = 0; r < 5; ++r) ps[wave * 320 + lane + 64 * r] = sc[r] * isum;
        __syncthreads();
        float o0 = 0.f, o1 = 0.f;
        for (int jrel = 0; jrel <= 256; ++jrel) { const int kp = pos - 128 + jrel; if (kp < 0 || kp >= SEQ) continue;
            const float p = ps[wave * 320 + jrel]; const bf16_t* vr = Z + (size_t)(b * SEQ + kp) * NIN + C_AV + kvh * 128; o0 += p * bf2f(vr[lane]); o1 += p * bf2f(vr[lane + 64]); }
        const bf16_t* gp = Z + (size_t)t * NIN + C_AG + hq * 128; bf16_t* yp = Yc + (size_t)t * 1024 + hq * 128;
        yp[lane] = f2bf(o0 * bf2f(gp[lane])); yp[lane + 64] = f2bf(o1 * bf2f(gp[lane + 64]));
        __syncthreads();
    }
}

__device__ void pool_naive(const Args& a, int l, float* P) {
    const bf16_t* Z = (const bf16_t*)(a.ws + WS_Z); bf16_t* Yb = (bf16_t*)(a.ws + WS_YB);
    const float* pw = a.in[5] + (size_t)l * 4 * 65536; const float* psc = a.in[6] + l * 1024;
    const int tid = otid();
    for (int tile = blockIdx.x; tile < T_TOK / 16; tile += gridDim.x) {
        const int t0 = tile * 16;
        for (int p = tid; p < 16 * 1024; p += NTHR) {
            const int tt = p >> 10, c = p & 1023, g = c >> 8, hw = 1 << g;
            const int t = t0 + tt, pos = t & (SEQ - 1), bb = t - pos;
            int lo = pos - hw, hi = pos + hw; lo = lo < 0 ? 0 : lo; hi = hi > SEQ ? SEQ : hi;
            float s = 0.f;
            for (int q = lo; q < hi; ++q) s += bf2f(Z[(size_t)(bb + q) * NIN + C_PV + c]);
            P[p] = s / (float)(hi - lo) - bf2f(Z[(size_t)t * NIN + C_PV + c]);
        }
        __syncthreads();
        for (int p = tid; p < 16 * 1024; p += NTHR) {
            const int tt = p >> 10, c = p & 1023, g = c >> 8, e = c & 255;
            const float* pp = P + tt * 1024 + g * 256; const float* wp = pw + (size_t)g * 65536 + e;
            float acc = 0.f;
            for (int d = 0; d < 256; ++d) acc += pp[d] * wp[(size_t)d * 256];
            const int t = t0 + tt;
            Yb[(size_t)t * 1024 + c] = f2bf(acc * psc[c] * bf2f(Z[(size_t)t * NIN + C_PG + c]));
        }
        __syncthreads();
    }
}

constexpr int N_PHASES = 1 + 5 * DEPTH;

__global__ void __launch_bounds__(NTHR, 2) mk_fwd(Args a) {
    extern __shared__ __attribute__((aligned(16))) unsigned char lds_raw[];
    LAS unsigned char* lds = (LAS unsigned char*)lds_raw;
    float* ldsf = (float*)lds_raw;
    unsigned char* ws = a.ws;
    const int lo = a.ph_lo, hi = a.ph_hi;
#ifndef PHMASK
#define PHMASK 0xff
#endif
#define IN(k) (lo <= (k) && (k) < hi)
#define SEAM(k) do { if (IN(k) && IN((k) + 1)) { cg::this_grid().sync(); } } while (0)
    if ((PHMASK & 1) && IN(0)) { prologue(a, ldsf); }
    SEAM(0);
    for (int l = 0; l < DEPTH; ++l) {
        const int pb = 1 + 5 * l;
        if ((PHMASK & 2) && IN(pb)) {
            InProj S{(const bf16_t*)(ws + WS_XB), (const bf16_t*)(ws + WS_WIN + l * SZ_WIN), (bf16_t*)(ws + WS_Z), (const float*)(ws + WS_ROWSS),
                     (const float*)(ws + WS_COSR), (const float*)(ws + WS_SINR), (int)gridDim.x, (int)blockIdx.x};
            pg8::gemm_phase<InProj>(lds, DM, S);
        }
        SEAM(pb);
        if (IN(pb + 1)) {
            if (PHMASK & 4) ret_scan_naive(a, l);
            if (PHMASK & 8) attn_naive(a, l, ldsf);
            if (PHMASK & 16) pool_naive(a, l, ldsf);
        }
        SEAM(pb + 1);
        if ((PHMASK & 32) && IN(pb + 2)) { ret_out_naive(a, l, ldsf); }
        SEAM(pb + 2);
        if ((PHMASK & 64) && IN(pb + 3)) {
            MergeP S{(const bf16_t*)(ws + WS_YA), (const bf16_t*)(ws + WS_WRET + l * SZ_WBR),
                     (const bf16_t*)(ws + WS_Z), (bf16_t*)(ws + WS_MG), (int)gridDim.x, (int)blockIdx.x};
            pg8::gemm_phase<MergeP>(lds, 1024, S);
        }
        SEAM(pb + 3);
        if ((PHMASK & 128) && IN(pb + 4)) {
            OutProj S{(const bf16_t*)(ws + WS_MG), (const bf16_t*)(ws + WS_WOUT + l * SZ_WOUT), l == 0 ? a.in[0] : a.out, a.out, (bf16_t*)(ws + WS_XB),
                      l + 1 < DEPTH ? (float*)(ws + WS_ROWSS) : nullptr, (int)gridDim.x, (int)blockIdx.x};
            pg8::gemm_phase<OutProj>(lds, DM, S);
        }
        SEAM(pb + 4);
    }
#undef IN
#undef SEAM
}

extern "C" void kernel_launch(void* const* d_in, const int* in_sizes, int n_in, void* d_out, int out_size, void* d_ws, size_t ws_size, hipStream_t stream) {
    static int grid = 0;
    if (grid == 0) {
        if (n_in != 14 || out_size != T_TOK * DM || ws_size < WS_END) { fprintf(stderr, "kernel_launch: unexpected shapes (n_in %d out %d ws %zu need %zu)\n", n_in, out_size, ws_size, (size_t)WS_END); grid = -1; return; }
        int dev = 0, cus = 0, per_cu = 0;
        hipGetDevice(&dev); hipDeviceGetAttribute(&cus, hipDeviceAttributeMultiprocessorCount, dev);
        if (hipFuncSetAttribute((const void*)mk_fwd, hipFuncAttributeMaxDynamicSharedMemorySize, LDS_BYTES) != hipSuccess) { fprintf(stderr, "kernel_launch: hipFuncSetAttribute failed\n"); grid = -1; return; }
        if (hipOccupancyMaxActiveBlocksPerMultiprocessor(&per_cu, (const void*)mk_fwd, NTHR, LDS_BYTES) != hipSuccess || per_cu < 1) { fprintf(stderr, "kernel_launch: occupancy query says %d\n", per_cu); per_cu = 1; }
        (void)hipGetLastError();
        grid = cus * 1;
    }
    if (grid < 0) return;
    Args a{};
    for (int i = 0; i < 14; ++i) a.in[i] = (const float*)d_in[i];
    a.out = (float*)d_out; a.ws = (unsigned char*)d_ws;
#if ONE_LAUNCH
    a.ph_lo = 0; a.ph_hi = N_PHASES;
    void* args[] = {&a};
    hipError_t e = hipLaunchCooperativeKernel((const void*)mk_fwd, dim3(grid), dim3(NTHR), args, LDS_BYTES, stream);
    if (e != hipSuccess) fprintf(stderr, "cooperative launch failed: %s (grid %d)\n", hipGetErrorString(e), grid);
#else
    for (int p = 0; p < N_PHASES; ++p) {
        a.ph_lo = p; a.ph_hi = p + 1;
        hipLaunchKernelGGL(mk_fwd, dim3(grid), dim3(NTHR), LDS_BYTES, stream, a);
    }
#endif
}
```

```cpp
#include <hip/hip_runtime.h>
#include <hip/hip_cooperative_groups.h>
#include <cstdio>
namespace cg = cooperative_groups;

#ifndef FAST_MIX
#define FAST_MIX 1
#endif
#ifndef FAST_ROUT
#define FAST_ROUT 1
#endif
#ifndef PROBE_DUP
#define PROBE_DUP 0
#endif
#ifndef ONE_LAUNCH
#define ONE_LAUNCH 1
#endif

#define LAS __attribute__((address_space(3)))
typedef unsigned short bf16_t;
typedef short bf16x8 __attribute__((ext_vector_type(8)));
typedef float f32x4 __attribute__((ext_vector_type(4)));
typedef unsigned u32x4 __attribute__((ext_vector_type(4)));
typedef unsigned u32x2 __attribute__((ext_vector_type(2)));

constexpr int T_TOK = 16384, DM = 2048, NIN = 14848, SEQ = 4096, DEPTH = 4;
constexpr int C_RQ = 0, C_RK = 1024, C_RV = 2048, C_RG = 3072, C_PV = 4096, C_PG = 5120, C_AQ = 6144, C_AK = 7168, C_AV = 7424, C_AG = 7680, C_MG = 8704;
constexpr int NTHR = 512;
constexpr int LDS_BYTES = 147456;

constexpr size_t SZ_WIN = (size_t)NIN * DM * 2, SZ_WBR = (size_t)DM * 1024 * 2, SZ_WOUT = (size_t)DM * DM * 2, SZ_PW = (size_t)4 * 256 * 256 * 2;
constexpr size_t WS_WIN = 0;
constexpr size_t WS_WRET = WS_WIN + DEPTH * SZ_WIN;
constexpr size_t WS_WPOOL = WS_WRET + DEPTH * SZ_WBR;
constexpr size_t WS_WATT = WS_WPOOL + DEPTH * SZ_WBR;
constexpr size_t WS_WOUT = WS_WATT + DEPTH * SZ_WBR;
constexpr size_t WS_PW = WS_WOUT + DEPTH * SZ_WOUT;
constexpr size_t WS_XB = WS_PW + DEPTH * SZ_PW;
constexpr size_t WS_Z = WS_XB + (size_t)T_TOK * DM * 2;
constexpr size_t WS_ROWSS = WS_Z + (size_t)T_TOK * NIN * 2;
constexpr size_t WS_SF = WS_ROWSS + (size_t)T_TOK * 32 * 4;
constexpr size_t SZ_ST = (size_t)16 * 32 * 65536 * 2;
constexpr size_t WS_SB = WS_SF + SZ_ST;
constexpr size_t WS_YA = WS_SB + SZ_ST;
constexpr size_t SZ_Y = (size_t)T_TOK * 1024 * 2;
constexpr size_t WS_YB = WS_YA + SZ_Y;
constexpr size_t WS_YC = WS_YB + SZ_Y;
constexpr size_t WS_MG = WS_YC + SZ_Y;
constexpr size_t WS_COSR = WS_MG + (size_t)T_TOK * DM * 2;
constexpr size_t WS_SINR = WS_COSR + (size_t)SEQ * 128 * 4;
constexpr size_t WS_COSA = WS_SINR + (size_t)SEQ * 128 * 4;
constexpr size_t WS_SINA = WS_COSA + (size_t)SEQ * 16 * 4;
constexpr size_t WS_CTR = WS_SINA + (size_t)SEQ * 16 * 4;
constexpr size_t WS_BAR = WS_CTR + 256;
constexpr size_t WS_END = WS_BAR + 16384;

struct Args { const float* in[14]; float* out; unsigned char* ws; int ph_lo, ph_hi; };

__device__ __forceinline__ float bf2f(bf16_t b) { return __uint_as_float(((unsigned)b) << 16); }
__device__ __forceinline__ unsigned cvt_pk_bf16(float lo, float hi) { unsigned r; asm volatile("v_cvt_pk_bf16_f32 %0, %1, %2" : "=v"(r) : "v"(lo), "v"(hi)); return r; }
__device__ __forceinline__ bf16_t f2bf(float f) { return (bf16_t)(cvt_pk_bf16(f, 0.f) & 0xffffu); }
__device__ __forceinline__ float lo16(unsigned w) { return __uint_as_float(w << 16); }
__device__ __forceinline__ float hi16(unsigned w) { return __uint_as_float(w & 0xffff0000u); }
__device__ __forceinline__ float wave_sum(float v) {
#pragma unroll
    for (int o = 32; o >= 1; o >>= 1) v += __shfl_xor(v, o);
    return v;
}
__device__ __forceinline__ float wave_max(float v) {
#pragma unroll
    for (int o = 32; o >= 1; o >>= 1) v = fmaxf(v, __shfl_xor(v, o));
    return v;
}
constexpr int WTAB_OFF = LDS_BYTES - 512;
__device__ __forceinline__ int otid() {
    const unsigned slot = (unsigned)__builtin_amdgcn_s_getreg((5 << 11) | 4) & 63u;
    const int wv = __builtin_amdgcn_readfirstlane(*(const LAS int*)((LAS unsigned char*)0 + WTAB_OFF + slot * 4));
    int t = wv * 64 + (int)__builtin_amdgcn_mbcnt_hi(~0u, __builtin_amdgcn_mbcnt_lo(~0u, 0u));
    asm volatile("" : "+v"(t)); return t; }
__device__ __forceinline__ void hw_sincos_rev(float rev, float& sn, float& cs) { const float f = __builtin_amdgcn_fractf(rev); sn = __builtin_amdgcn_sinf(f); cs = __builtin_amdgcn_cosf(f); }
__device__ __forceinline__ float silu_f(float v) { return v * __builtin_amdgcn_rcpf(1.f + __expf(-v)); }
__device__ __forceinline__ float sigm_f(float v) { return __builtin_amdgcn_rcpf(1.f + __expf(-v)); }
__device__ __forceinline__ void sincos_red(float ang, float& s, float& c) {
    const double a = (double)ang; const double k = rint(a * 0.15915494309189535); const float r = (float)(a - k * 6.283185307179586);
    s = sinf(r); c = cosf(r);
}

namespace pg8 {
constexpr int BM = 256, BK = 64, HALF = 128, HTB = HALF * BK * 2, STAGE_BYTES = 8 * HTB, NXCD = 8, WGM = 8;
__device__ __forceinline__ int lds_byte(int r, int c) { const int st = (r >> 4) * 2 + (c >> 5), rr = r & 15, cc = c & 31, ob = rr * 64 + cc * 2; return st * 1024 + (ob ^ (((ob >> 9) & 1) << 5)); }
__device__ __forceinline__ void stage_rc(int b, int& R, int& C) { const int st = b / 1024, sb = b % 1024, swz = sb ^ (((sb >> 9) & 1) << 5); R = (st >> 1) * 16 + swz / 64; C = (st & 1) * 32 + (swz % 64) / 2; }
__device__ __forceinline__ int perm32(int rho) { const int n = rho >> 4, i = rho & 15; return 8 * (i >> 2) + 4 * n + (i & 3); }
struct Unit { const char* a; const char* b; int pm, pn, sub; };
__device__ __forceinline__ bool tile_order(long L, int nM, int nN, int& pm, int& pn) {
    const int nwg = nM * nN; if (L >= nwg) return false;
    int wgid = (int)L; { const int q = nwg / NXCD, r = nwg % NXCD, xcd = wgid % NXCD, off = wgid / NXCD; wgid = (xcd < r ? xcd * (q + 1) : r * (q + 1) + (xcd - r) * q) + off; }
    const int nig = WGM * nN, gid = wgid / nig, fm = gid * WGM, gsz = (nM - fm) < WGM ? (nM - fm) : WGM;
    pm = fm + ((wgid % nig) % gsz); pn = (wgid % nig) / gsz; return true;
}
template <class Prog>
__device__ __forceinline__ void gemm_phase(LAS unsigned char* lds, const int K, const Prog& S) {
    int tid_ = otid();
    const int tid = tid_, wid = __builtin_amdgcn_readfirstlane(tid >> 6), lane = tid & 63, wr = wid >> 2, wc = wid & 3, fr = lane & 15, fq = lane >> 4;
    const int nt = K / BK;
    unsigned voffA[2], voffB[2];
#pragma unroll
    for (int i = 0; i < 2; ++i) { int R, C; stage_rc(tid * 16 + i * 8192, R, C); const int Rb = Prog::PERM ? ((R & ~31) + perm32(R & 31)) : R;
        voffA[i] = (unsigned)(R * K + C) * 2u; voffB[i] = (unsigned)(Rb * K + C) * 2u; }
    const size_t kstep = (size_t)(BK * 2);
    const size_t hstep = (size_t)HALF * K * 2;
    const unsigned ldsw = (unsigned)wid * 1024u;
    const int aoff = lds_byte(wr * 64 + fr, fq * 8), boff = lds_byte(wc * 32 + fr, fq * 8);
#define PG8_SA(b, h) (((b) * 2 + (h)) * HTB)
#define PG8_SB(b, h) ((4 + (b) * 2 + (h)) * HTB)
#define PG8_STAGE(bufoff, gbase, voff) do { _Pragma("unroll") for (int _i = 0; _i < 2; ++_i) \
        __builtin_amdgcn_global_load_lds((const unsigned*)((const char*)(gbase) + (voff)[_i]), (LAS unsigned*)(lds + (bufoff) + ldsw + _i * 8192), 16, 0, 0); } while (0)
#define PG8_LDA(dst, b, h) do { _Pragma("unroll") for (int m = 0; m < 4; ++m) _Pragma("unroll") for (int k = 0; k < 2; ++k) dst[m][k] = *(const LAS bf16x8*)(lds + PG8_SA(b, h) + aoff + m * 2048 + k * 1024); } while (0)
#define PG8_LDB(dst, b, h) do { _Pragma("unroll") for (int n = 0; n < 2; ++n) _Pragma("unroll") for (int k = 0; k < 2; ++k) dst[n][k] = *(const LAS bf16x8*)(lds + PG8_SB(b, h) + boff + n * 2048 + k * 1024); } while (0)
#define PG8_MMA(ai, bj, At, Bt) do { __builtin_amdgcn_s_setprio(1); _Pragma("unroll") for (int m = 0; m < 4; ++m) _Pragma("unroll") for (int n = 0; n < 2; ++n) _Pragma("unroll") for (int k = 0; k < 2; ++k) \
        acc[ai][bj][m][n] = __builtin_amdgcn_mfma_f32_16x16x32_bf16(Bt[n][k], At[m][k], acc[ai][bj][m][n], 0, 0, 0); __builtin_amdgcn_s_setprio(0); } while (0)
#define PG8_WAIT_V(n) asm volatile("s_waitcnt vmcnt(" #n ")" ::: "memory")
#define PG8_WAIT_L(n) asm volatile("s_waitcnt lgkmcnt(" #n ")" ::: "memory")
#define PG8_BAR __builtin_amdgcn_s_barrier()
#define PG8_SCHED __builtin_amdgcn_sched_barrier(0)
    Unit cur, nxt; int ui = 0;
    if (!S.next(0, cur)) return;
    f32x4 acc[2][2][4][2];
#pragma unroll
    for (int a = 0; a < 2; ++a)
#pragma unroll
        for (int b = 0; b < 2; ++b)
#pragma unroll
            for (int m = 0; m < 4; ++m)
#pragma unroll
                for (int n = 0; n < 2; ++n) acc[a][b][m][n] = (f32x4){0.f, 0.f, 0.f, 0.f};
    bf16x8 At[4][2], B0[2][2], B1[2][2];
    const char* cA = cur.a; const char* cB = cur.b;
    PG8_STAGE(PG8_SB(0, 0), cB, voffB); PG8_STAGE(PG8_SA(0, 0), cA, voffA); PG8_STAGE(PG8_SB(0, 1), cB + hstep, voffB); PG8_STAGE(PG8_SA(0, 1), cA + hstep, voffA);
    if (wr == 1) PG8_BAR;
    PG8_WAIT_V(4); PG8_BAR;
    PG8_STAGE(PG8_SB(1, 0), cB + kstep, voffB); PG8_STAGE(PG8_SA(1, 0), cA + kstep, voffA); PG8_STAGE(PG8_SB(1, 1), cB + hstep + kstep, voffB);
    PG8_WAIT_V(6); PG8_BAR;
    for (;;) {
        const bool has_next = S.next(ui + 1, nxt);
        const char* nA = has_next ? nxt.a : cA; const char* nB = has_next ? nxt.b : cB;
        for (int t = 0; t < nt; t += 2) {
            const bool last = (t == nt - 2);
            const char* a1 = cA + (size_t)(t + 1) * kstep;
            const char* a2 = last ? nA : cA + (size_t)(t + 2) * kstep; const char* b2 = last ? nB : cB + (size_t)(t + 2) * kstep;
            const char* a3 = a2 + kstep; const char* b3 = b2 + kstep;
            PG8_LDB(B0, 0, 0); PG8_SCHED; PG8_LDA(At, 0, 0); PG8_STAGE(PG8_SA(1, 1), a1 + hstep, voffA);
            PG8_WAIT_L(8); PG8_BAR; PG8_WAIT_L(0); PG8_MMA(0, 0, At, B0); PG8_BAR; PG8_SCHED;
            PG8_LDB(B1, 0, 1); PG8_STAGE(PG8_SB(0, 0), b2, voffB);
            PG8_BAR; PG8_WAIT_L(0); PG8_MMA(0, 1, At, B1); PG8_BAR;
            PG8_LDA(At, 0, 1); PG8_STAGE(PG8_SA(0, 0), a2, voffA);
            PG8_BAR; PG8_WAIT_L(0); PG8_MMA(1, 0, At, B0); PG8_BAR; PG8_SCHED;
            PG8_STAGE(PG8_SB(0, 1), b2 + hstep, voffB);
            PG8_WAIT_V(6); PG8_BAR; PG8_MMA(1, 1, At, B1); PG8_BAR;
            PG8_LDB(B0, 1, 0); PG8_SCHED; PG8_LDA(At, 1, 0); PG8_STAGE(PG8_SA(0, 1), a2 + hstep, voffA);
            PG8_WAIT_L(8); PG8_BAR; PG8_WAIT_L(0); PG8_MMA(0, 0, At, B0); PG8_BAR; PG8_SCHED;
            PG8_LDB(B1, 1, 1); PG8_STAGE(PG8_SB(1, 0), b3, voffB);
            PG8_BAR; PG8_WAIT_L(0); PG8_MMA(0, 1, At, B1); PG8_BAR;
            PG8_LDA(At, 1, 1); PG8_STAGE(PG8_SA(1, 0), a3, voffA);
            PG8_BAR; PG8_WAIT_L(0); PG8_MMA(1, 0, At, B0); PG8_BAR; PG8_SCHED;
            PG8_STAGE(PG8_SB(1, 1), b3 + hstep, voffB);
            PG8_WAIT_V(6); PG8_BAR; PG8_MMA(1, 1, At, B1); PG8_BAR;
        }
        S.epi(acc, cur, wr, wc, fr, fq);
        if (!S.keep(cur)) {
#pragma unroll
            for (int a = 0; a < 2; ++a)
#pragma unroll
                for (int b = 0; b < 2; ++b)
#pragma unroll
                    for (int m = 0; m < 4; ++m)
#pragma unroll
                        for (int n = 0; n < 2; ++n) acc[a][b][m][n] = (f32x4){0.f, 0.f, 0.f, 0.f};
        }
        if (!has_next) break;
        cur = nxt; cA = nA; cB = nB; ++ui;
    }
    PG8_WAIT_V(0);
    if (wr == 0) PG8_BAR;
    PG8_BAR;
#undef PG8_SA
#undef PG8_SB
#undef PG8_STAGE
#undef PG8_LDA
#undef PG8_LDB
#undef PG8_MMA
#undef PG8_WAIT_V
#undef PG8_WAIT_L
#undef PG8_BAR
#undef PG8_SCHED
}
}

struct InProj {
    static constexpr bool PERM = true;
    const bf16_t* A; const bf16_t* Bt; bf16_t* Z; const float* rowss; const float* cosR; const float* sinR; int G, c;
    int pm0; const LAS float* rsl;
    __device__ __forceinline__ bool next(int i, pg8::Unit& u) const {
        if (!pg8::tile_order((long)i * G + c, T_TOK / 256, NIN / 256, u.pm, u.pn)) return false;
        u.a = (const char*)(A + (size_t)u.pm * 256 * DM); u.b = (const char*)(Bt + (size_t)u.pn * 256 * DM); u.sub = 0; return true;
    }
    __device__ __forceinline__ bool keep(const pg8::Unit&) const { return false; }
    __device__ __forceinline__ void epi(f32x4 (&acc)[2][2][4][2], const pg8::Unit& u, int wr, int wc, int fr, int fq) const {
        const int row0 = u.pm * 256 + wr * 64 + fr, col0 = u.pn * 256 + wc * 32 + 8 * fq;
        const int pn = u.pn;
        const int mode = (pn < 8) ? 1 : ((pn >= 12 && pn < 16) || (pn >= 20 && pn < 24) || (pn >= 30 && pn < 34)) ? 2 : (pn >= 34 ? 3 : 0);
        const float ksc = (pn >= 4 && pn < 8) ? 0.0625f : 1.0f;
        float rsv[2][4];
        if (u.pm == pm0) {
#pragma unroll
            for (int ai = 0; ai < 2; ++ai)
#pragma unroll
                for (int m = 0; m < 4; ++m) rsv[ai][m] = rsl[ai * 128 + wr * 64 + m * 16 + fr];
        } else {
            f32x4 pa[2][4], pb[2][4];
#pragma unroll
            for (int ai = 0; ai < 2; ++ai)
#pragma unroll
                for (int m = 0; m < 4; ++m) { const f32x4* rp = (const f32x4*)(rowss + (size_t)(row0 + ai * 128 + m * 16) * 32) + fq * 2; pa[ai][m] = rp[0]; pb[ai][m] = rp[1]; }
#pragma unroll
            for (int ai = 0; ai < 2; ++ai)
#pragma unroll
                for (int m = 0; m < 4; ++m) { const f32x4 t4 = pa[ai][m] + pb[ai][m]; float sm = (t4[0] + t4[1]) + (t4[2] + t4[3]); sm += __shfl_xor(sm, 16); sm += __shfl_xor(sm, 32);
                    rsv[ai][m] = rsqrtf(sm * (1.0f / DM) + 1e-6f); }
        }
        if (mode == 1) {
            f32x4 ci[2];
#pragma unroll
            for (int n = 0; n < 2; ++n)
#pragma unroll
                for (int j = 0; j < 4; ++j) ci[n][j] = exp2f(-(float)(wc * 32 + 8 * fq + 4 * n + j) * (13.287712379549449f / 127.0f)) * 0.15915494309189535f;
#pragma unroll
            for (int ai = 0; ai < 2; ++ai) {
#pragma unroll
                for (int m = 0; m < 4; ++m) {
                    const int row = row0 + ai * 128 + m * 16; const float rs = rsv[ai][m] * ksc; const float fp = (float)(row & (SEQ - 1));
                    bf16_t* rowp = Z + (size_t)row * NIN + col0;
                    f32x4 o0[2], o1[2];
#pragma unroll
                    for (int n = 0; n < 2; ++n) { f32x4 cs, sn;
#pragma unroll
                        for (int j = 0; j < 4; ++j) { float sa, ca; hw_sincos_rev(fp * ci[n][j], sa, ca); sn[j] = sa; cs[j] = ca; }
                        const f32x4 x1 = acc[ai][0][m][n] * rs, x2 = acc[ai][1][m][n] * rs; o0[n] = x1 * cs - x2 * sn; o1[n] = x2 * cs + x1 * sn; }
                    u32x4 w; w.x = cvt_pk_bf16(o0[0][0], o0[0][1]); w.y = cvt_pk_bf16(o0[0][2], o0[0][3]); w.z = cvt_pk_bf16(o0[1][0], o0[1][1]); w.w = cvt_pk_bf16(o0[1][2], o0[1][3]);
                    *(u32x4*)(rowp) = w;
                    w.x = cvt_pk_bf16(o1[0][0], o1[0][1]); w.y = cvt_pk_bf16(o1[0][2], o1[0][3]); w.z = cvt_pk_bf16(o1[1][0], o1[1][1]); w.w = cvt_pk_bf16(o1[1][2], o1[1][3]);
                    *(u32x4*)(rowp + 128) = w;
                }
            }
            return;
        }
#pragma unroll
        for (int ai = 0; ai < 2; ++ai)
#pragma unroll
            for (int m = 0; m < 4; ++m) {
                const int row = row0 + ai * 128 + m * 16;
                const float rs = rsv[ai][m];
                f32x4 v[2][2];
#pragma unroll
                for (int bj = 0; bj < 2; ++bj)
#pragma unroll
                    for (int n = 0; n < 2; ++n) v[bj][n] = acc[ai][bj][m][n] * rs;
                if (mode == 2) {
#pragma unroll
                    for (int bj = 0; bj < 2; ++bj)
#pragma unroll
                        for (int n = 0; n < 2; ++n)
#pragma unroll
                            for (int j = 0; j < 4; ++j) v[bj][n][j] = silu_f(v[bj][n][j]);
                } else if (mode == 3) {
#pragma unroll
                    for (int bj = 0; bj < 2; ++bj)
#pragma unroll
                        for (int n = 0; n < 2; ++n)
#pragma unroll
                            for (int j = 0; j < 4; ++j) v[bj][n][j] = sigm_f(v[bj][n][j]);
                }
                bf16_t* rowp = Z + (size_t)row * NIN + col0;
#pragma unroll
                for (int bj = 0; bj < 2; ++bj) {
                    u32x4 w; w.x = cvt_pk_bf16(v[bj][0][0], v[bj][0][1]); w.y = cvt_pk_bf16(v[bj][0][2], v[bj][0][3]); w.z = cvt_pk_bf16(v[bj][1][0], v[bj][1][1]); w.w = cvt_pk_bf16(v[bj][1][2], v[bj][1][3]);
                    *(u32x4*)(rowp + bj * 128) = w;
                }
            }
    }
};

struct MergeP {
    static constexpr bool PERM = true;
    const bf16_t *Y0, *W0; const bf16_t* Z; bf16_t* Mg; int G, c;
    __device__ __forceinline__ bool next(int i, pg8::Unit& u) const {
        const int ti = i / 3; u.sub = i - ti * 3;
        if (!pg8::tile_order((long)ti * G + c, T_TOK / 256, DM / 256, u.pm, u.pn)) return false;
        const bf16_t* yy = Y0 + (size_t)u.sub * (SZ_Y / 2); const bf16_t* ww = W0 + (size_t)u.sub * (DEPTH * SZ_WBR / 2);
        u.a = (const char*)(yy + (size_t)u.pm * 256 * 1024); u.b = (const char*)(ww + (size_t)u.pn * 256 * 1024); return true;
    }
    __device__ __forceinline__ bool keep(const pg8::Unit& u) const { return u.sub < 2; }
    __device__ __forceinline__ void epi(f32x4 (&acc)[2][2][4][2], const pg8::Unit& u, int wr, int wc, int fr, int fq) const {
        const int row0 = u.pm * 256 + wr * 64 + fr, col0 = u.pn * 256 + wc * 32 + 8 * fq;
        const int sub = u.sub;
        u32x4 gn[4][2][2], gd[4][2][2];
        const int dsub = sub < 2 ? sub + 1 : sub;
#define MG_LOAD(q) do { _Pragma("unroll") for (int mm = 0; mm < 2; ++mm) _Pragma("unroll") for (int bj = 0; bj < 2; ++bj) { \
            const bf16_t* gp = Z + (size_t)(row0 + ((q) >> 1) * 128 + (((q) & 1) * 2 + mm) * 16) * NIN + C_MG + col0 + bj * 128; \
            gn[q][mm][bj] = *(const u32x4*)(gp + sub * DM); gd[q][mm][bj] = *(const u32x4*)(gp + dsub * DM); } } while (0)
#define MG_APPLY(q) do { _Pragma("unroll") for (int mm = 0; mm < 2; ++mm) _Pragma("unroll") for (int bj = 0; bj < 2; ++bj) { \
            const int ai = (q) >> 1, m = ((q) & 1) * 2 + mm; const u32x4 a4 = gn[q][mm][bj], d4 = gd[q][mm][bj]; \
            f32x4 f0 = (f32x4){lo16(a4[0]), hi16(a4[0]), lo16(a4[1]), hi16(a4[1])}, f1 = (f32x4){lo16(a4[2]), hi16(a4[2]), lo16(a4[3]), hi16(a4[3])}; \
            if (sub < 2) { \
                f0[0] *= __builtin_amdgcn_rcpf(lo16(d4[0])); f0[1] *= __builtin_amdgcn_rcpf(hi16(d4[0])); f0[2] *= __builtin_amdgcn_rcpf(lo16(d4[1])); f0[3] *= __builtin_amdgcn_rcpf(hi16(d4[1])); \
                f1[0] *= __builtin_amdgcn_rcpf(lo16(d4[2])); f1[1] *= __builtin_amdgcn_rcpf(hi16(d4[2])); f1[2] *= __builtin_amdgcn_rcpf(lo16(d4[3])); f1[3] *= __builtin_amdgcn_rcpf(hi16(d4[3])); } \
            acc[ai][bj][m][0] *= f0; acc[ai][bj][m][1] *= f1; \
            if (sub == 2) { const f32x4 v0 = acc[ai][bj][m][0], v1 = acc[ai][bj][m][1]; \
                u32x4 w; w.x = cvt_pk_bf16(v0[0], v0[1]); w.y = cvt_pk_bf16(v0[2], v0[3]); w.z = cvt_pk_bf16(v1[0], v1[1]); w.w = cvt_pk_bf16(v1[2], v1[3]); \
                *(u32x4*)(Mg + (size_t)(row0 + ai * 128 + m * 16) * DM + col0 + bj * 128) = w; } } } while (0)
        MG_LOAD(0); MG_LOAD(1);
        MG_APPLY(0); MG_LOAD(2);
        MG_APPLY(1); MG_LOAD(3);
        MG_APPLY(2); MG_APPLY(3);
#undef MG_LOAD
#undef MG_APPLY
    }
};

struct OutProj {
    static constexpr bool PERM = false;
    const bf16_t* A; const bf16_t* Bt; const float* xin; float* xout; bf16_t* xb; float* rowss_next; int G, c;
    __device__ __forceinline__ bool next(int i, pg8::Unit& u) const {
        if (!pg8::tile_order((long)i * G + c, T_TOK / 256, DM / 256, u.pm, u.pn)) return false;
        u.a = (const char*)(A + (size_t)u.pm * 256 * DM); u.b = (const char*)(Bt + (size_t)u.pn * 256 * DM); u.sub = 0; return true;
    }
    __device__ __forceinline__ bool keep(const pg8::Unit&) const { return false; }
    __device__ __forceinline__ void epi(f32x4 (&acc)[2][2][4][2], const pg8::Unit& u, int wr, int wc, int fr, int fq) const {
        const int row0 = u.pm * 256 + wr * 64 + fr, col0 = u.pn * 256 + wc * 32 + 4 * fq;
#pragma unroll
        for (int ai = 0; ai < 2; ++ai) {
            f32x4 xo[4][2][2];
#pragma unroll
            for (int m = 0; m < 4; ++m)
#pragma unroll
                for (int bj = 0; bj < 2; ++bj)
#pragma unroll
                    for (int n = 0; n < 2; ++n) xo[m][bj][n] = *(const f32x4*)(xin + (size_t)(row0 + ai * 128 + m * 16) * DM + col0 + bj * 128 + n * 16);
#pragma unroll
            for (int m = 0; m < 4; ++m) {
                const int row = row0 + ai * 128 + m * 16;
                const size_t off = (size_t)row * DM + col0;
                float ss = 0.f;
#pragma unroll
                for (int bj = 0; bj < 2; ++bj)
#pragma unroll
                    for (int n = 0; n < 2; ++n) {
                        const f32x4 o = xo[m][bj][n] + acc[ai][bj][m][n];
                        *(f32x4*)(xout + off + bj * 128 + n * 16) = o;
                        ss += o[0] * o[0] + o[1] * o[1] + o[2] * o[2] + o[3] * o[3];
                        if (rowss_next) { u32x2 w; w.x = cvt_pk_bf16(o[0], o[1]); w.y = cvt_pk_bf16(o[2], o[3]); *(u32x2*)(xb + off + bj * 128 + n * 16) = w; }
                    }
                if (rowss_next) {
                    ss += __shfl_xor(ss, 16); ss += __shfl_xor(ss, 32);
                    if (fq == 0) rowss_next[(size_t)row * 32 + u.pn * 4 + wc] = ss;
                }
            }
        }
    }
};

__device__ void tconv(const float* __restrict__ src, bf16_t* __restrict__ dst, int R, int C, const float* __restrict__ scale, float* tile) {
    const int tid = otid();
    const int ntc = C / 256, nt = (R / 64) * ntc;
    for (int t = blockIdx.x; t < nt; t += gridDim.x) {
        const int tr = t / ntc, tc = t - tr * ntc;
        {
            const int c4 = (tid & 63) * 4, r0 = tid >> 6;
            float4 v[8];
#pragma unroll
            for (int i = 0; i < 8; ++i) v[i] = *(const float4*)(src + (size_t)(tr * 64 + r0 + 8 * i) * C + tc * 256 + c4);
#pragma unroll
            for (int i = 0; i < 8; ++i) { const float sc = scale ? scale[tr * 64 + r0 + 8 * i] : 1.f; float* tp = tile + (r0 + 8 * i) * 257 + c4;
                tp[0] = v[i].x * sc; tp[1] = v[i].y * sc; tp[2] = v[i].z * sc; tp[3] = v[i].w * sc; }
        }
        __syncthreads();
#pragma unroll
        for (int i = 0; i < 4; ++i) {
            const int c = tid + 512 * i, kc = c & 7, n = c >> 3;
            const float* tp = tile + (kc * 8) * 257 + n;
            u32x4 o; o.x = cvt_pk_bf16(tp[0], tp[257]); o.y = cvt_pk_bf16(tp[514], tp[771]); o.z = cvt_pk_bf16(tp[1028], tp[1285]); o.w = cvt_pk_bf16(tp[1542], tp[1799]);
            *(u32x4*)(dst + (size_t)(tc * 256 + n) * R + tr * 64 + kc * 8) = o;
        }
        __syncthreads();
    }
}

__device__ void prologue(const Args& a, float* lds) {
    unsigned char* ws = a.ws;
    const int tid = otid(), lane = tid & 63, wave = tid >> 6;
    const size_t gtid = (size_t)blockIdx.x * NTHR + tid, gstr = (size_t)gridDim.x * NTHR;
    {
        const float* x = a.in[0]; bf16_t* xb = (bf16_t*)(ws + WS_XB); float* rowss = (float*)(ws + WS_ROWSS);
        for (int row = blockIdx.x * 8 + wave; row < T_TOK; row += gridDim.x * 8) {
            const float4* xp = (const float4*)(x + (size_t)row * DM); float ss = 0.f;
#pragma unroll
            for (int i = 0; i < 8; ++i) { const float4 v = xp[lane + 64 * i]; ss += v.x * v.x + v.y * v.y + v.z * v.z + v.w * v.w;
                u32x2 o; o.x = cvt_pk_bf16(v.x, v.y); o.y = cvt_pk_bf16(v.z, v.w); *(u32x2*)(xb + (size_t)row * DM + (lane + 64 * i) * 4) = o; }
            ss = wave_sum(ss);
            if (lane < 32) rowss[(size_t)row * 32 + lane] = lane == 0 ? ss : 0.f;
        }
    }
    if (blockIdx.x == 0) { if (tid < 64) ((unsigned*)(ws + WS_CTR))[tid] = 0u; for (int i = tid; i < 4096; i += NTHR) ((unsigned*)(ws + WS_BAR))[i] = 0u; }
    {
        float* cR = (float*)(ws + WS_COSR); float* sR = (float*)(ws + WS_SINR); float* cA = (float*)(ws + WS_COSA); float* sA = (float*)(ws + WS_SINA);
        for (size_t i = gtid; i < (size_t)SEQ * 128; i += gstr) { const int s = (int)(i >> 7), k = (int)(i & 127);
            const float inv = 1.0f / exp2f((float)k * (1.0f / 127.0f) * 13.287712379549449f); float sn, cs; sincos_red((float)s * inv, sn, cs); cR[i] = cs; sR[i] = sn; }
        for (size_t i = gtid; i < (size_t)SEQ * 16; i += gstr) { const int s = (int)(i >> 4), k = (int)(i & 15);
            const float inv = exp2f(-(float)k * (1.0f / 16.0f) * 18.931568569324174f); float sn, cs; sincos_red((float)s * inv, sn, cs); cA[i] = cs; sA[i] = sn; }
    }
    for (int l = 0; l < DEPTH; ++l) {
        tconv(a.in[2] + (size_t)l * DM * NIN, (bf16_t*)(ws + WS_WIN + l * SZ_WIN), DM, NIN, a.in[1] + l * DM, lds);
        tconv(a.in[10] + (size_t)l * 1024 * DM, (bf16_t*)(ws + WS_WRET + l * SZ_WBR), 1024, DM, nullptr, lds);
        tconv(a.in[11] + (size_t)l * 1024 * DM, (bf16_t*)(ws + WS_WPOOL + l * SZ_WBR), 1024, DM, nullptr, lds);
        tconv(a.in[12] + (size_t)l * 1024 * DM, (bf16_t*)(ws + WS_WATT + l * SZ_WBR), 1024, DM, nullptr, lds);
        tconv(a.in[13] + (size_t)l * DM * DM, (bf16_t*)(ws + WS_WOUT + l * SZ_WOUT), DM, DM, nullptr, lds);
        for (int g = 0; g < 4; ++g) tconv(a.in[5] + ((size_t)l * 4 + g) * 65536, (bf16_t*)(ws + WS_PW + l * SZ_PW) + g * 65536, 256, 256, nullptr, lds);
    }
}

__device__ void ret_scan_naive(const Args& a, int l) {
    const bf16_t* Z = (const bf16_t*)(a.ws + WS_Z);
    const size_t gtid = (size_t)blockIdx.x * NTHR + otid(), gstr = (size_t)gridDim.x * NTHR;
    for (size_t idx = gtid; idx < (size_t)2097152; idx += gstr) {
        const int d = (int)(idx & 255), e = (int)((idx >> 8) & 255), dir = (int)((idx >> 16) & 1), bh = (int)(idx >> 17), b = bh >> 2, h = bh & 3;
        const float lg = -expf(a.in[dir ? 4 : 3][l * 4 + h]);
        const float dec = expf(lg * 128.f);
        bf16_t* ST = (bf16_t*)(a.ws + (dir ? WS_SB : WS_SF));
        float st = 0.f;
        for (int step = 0; step < 32; ++step) {
            const int n = dir ? 31 - step : step;
            ST[(((size_t)bh * 32 + n) * 256 + e) * 256 + d] = f2bf(st);
            float kv = 0.f;
            const bf16_t* zp = Z + (size_t)(b * SEQ + n * 128) * NIN + h * 256;
            for (int j = 0; j < 128; ++j) {
                const float w = dir ? expf(lg * (float)j) : expf(lg * (float)(127 - j));
                kv += bf2f(zp[(size_t)j * NIN + C_RK + d]) * w * bf2f(zp[(size_t)j * NIN + C_RV + e]);
            }
            st = st * dec + kv;
        }
    }
}

__device__ void ret_out_naive(const Args& a, int l, float* P) {
    const bf16_t* Z = (const bf16_t*)(a.ws + WS_Z); bf16_t* Ya = (bf16_t*)(a.ws + WS_YA);
    const bf16_t* SF = (const bf16_t*)(a.ws + WS_SF); const bf16_t* SB = (const bf16_t*)(a.ws + WS_SB);
    const int tid = otid();
    for (int item = blockIdx.x; item < 512; item += gridDim.x) {
        const int b = item >> 7, n = (item >> 2) & 31, h = item & 3, bh = b * 4 + h;
        const int t0 = b * SEQ + n * 128;
        const float lgf = -expf(a.in[3][l * 4 + h]), lgb = -expf(a.in[4][l * 4 + h]);
        for (int p = tid; p < 16384; p += NTHR) {
            const int j = p >> 7, k = p & 127;
            const bf16_t* qp = Z + (size_t)(t0 + j) * NIN + C_RQ + h * 256; const bf16_t* kp = Z + (size_t)(t0 + k) * NIN + C_RK + h * 256;
            float dot = 0.f;
            for (int d = 0; d < 256; ++d) dot += bf2f(qp[d]) * bf2f(kp[d]);
            const int lag = j - k;
            P[p] = dot * (lag >= 0 ? expf(lgf * (float)lag) : expf(lgb * (float)(-lag)));
        }
        __syncthreads();
        for (int pass = 0; pass < 4; ++pass) {
            const int j = pass * 32 + (tid >> 4), eg = tid & 15;
            float o[16];
#pragma unroll
            for (int i = 0; i < 16; ++i) o[i] = 0.f;
            for (int k = 0; k < 128; ++k) {
                const float pv = P[j * 128 + k];
                const bf16_t* vp = Z + (size_t)(t0 + k) * NIN + C_RV + h * 256 + eg * 16;
#pragma unroll
                for (int i = 0; i < 16; ++i) o[i] += pv * bf2f(vp[i]);
            }
            const bf16_t* qp = Z + (size_t)(t0 + j) * NIN + C_RQ + h * 256;
            const float qf = expf(lgf * (float)(j + 1)), qb = expf(lgb * (float)(128 - j));
#pragma unroll
            for (int i = 0; i < 16; ++i) {
                const size_t so = (((size_t)bh * 32 + n) * 256 + eg * 16 + i) * 256;
                float cf = 0.f, cb = 0.f;
                for (int d = 0; d < 256; ++d) { const float qv = bf2f(qp[d]); cf += qv * bf2f(SF[so + d]); cb += qv * bf2f(SB[so + d]); }
                o[i] += qf * cf + qb * cb;
            }
            float ss = 0.f;
#pragma unroll
            for (int i = 0; i < 16; ++i) ss += o[i] * o[i];
            ss += __shfl_xor(ss, 1); ss += __shfl_xor(ss, 2); ss += __shfl_xor(ss, 4); ss += __shfl_xor(ss, 8);
            const float rs = rsqrtf(ss * (1.0f / 256.0f) + 1e-6f);
            const bf16_t* gp = Z + (size_t)(t0 + j) * NIN + C_RG + h * 256 + eg * 16;
            bf16_t* yp = Ya + (size_t)(t0 + j) * 1024 + h * 256 + eg * 16;
#pragma unroll
            for (int i = 0; i < 16; ++i) yp[i] = f2bf(o[i] * rs * bf2f(gp[i]));
        }
        __syncthreads();
    }
}

__device__ void attn_naive(const Args& a, int l, float* lds) {
    const bf16_t* Z = (const bf16_t*)(a.ws + WS_Z); bf16_t* Yc = (bf16_t*)(a.ws + WS_YC);
    const float* cA = (const float*)(a.ws + WS_COSA); const float* sA = (const float*)(a.ws + WS_SINA);
    const float* qg = a.in[7] + l * 128; const float* kg = a.in[8] + l * 128; const float* sink = a.in[9] + l * 8;
    float* qs = lds; float* ps = lds + 8 * 128;
    const int tid = otid(), lane = tid & 63, wave = tid >> 6;
    for (int w0 = blockIdx.x * 8; w0 < T_TOK * 8; w0 += gridDim.x * 8) {
        const int qi = w0 + wave, t = qi >> 3, hq = qi & 7, kvh = hq >> 2, pos = t & (SEQ - 1), b = t >> 12;
        const bf16_t* qp = Z + (size_t)t * NIN + C_AQ + hq * 128;
        {
            const float x0 = bf2f(qp[lane]), x1 = bf2f(qp[lane + 64]);
            const float ss = wave_sum(x0 * x0 + x1 * x1); const float rs = rsqrtf(ss * (1.0f / 128.0f) + 1e-6f);
            qs[wave * 128 + lane] = x0 * rs * qg[lane]; qs[wave * 128 + lane + 64] = x1 * rs * qg[lane + 64];
        }
        __syncthreads();
        float rot = 0.f;
        if (lane < 32) { const int i = lane & 15; const float xa = qs[wave * 128 + i], xb = qs[wave * 128 + i + 16], c = cA[pos * 16 + i], s = sA[pos * 16 + i]; rot = lane < 16 ? xa * c - xb * s : xb * c + xa * s; }
        __syncthreads();
        if (lane < 32) qs[wave * 128 + lane] = rot;
        __syncthreads();
        float sc[5]; const float skv = sink[hq]; float mx = skv;
#pragma unroll
        for (int r = 0; r < 5; ++r) {
            const int jrel = lane + 64 * r, kp = pos - 128 + jrel; const bool valid = (jrel <= 256) && (kp >= 0) && (kp < SEQ);
            float s = -1e30f;
            if (valid) {
                const bf16_t* kr = Z + (size_t)(b * SEQ + kp) * NIN + C_AK + kvh * 128;
                float kss = 0.f;
                for (int d = 0; d < 128; ++d) { const float kv = bf2f(kr[d]); kss += kv * kv; }
                const float rsk = rsqrtf(kss * (1.0f / 128.0f) + 1e-6f);
                float dot = 0.f;
                for (int i = 0; i < 16; ++i) { const float xa = bf2f(kr[i]) * kg[i], xb = bf2f(kr[i + 16]) * kg[i + 16], c = cA[kp * 16 + i], sn = sA[kp * 16 + i];
                    dot += (xa * c - xb * sn) * qs[wave * 128 + i] + (xb * c + xa * sn) * qs[wave * 128 + i + 16]; }
                for (int d = 32; d < 128; ++d) dot += bf2f(kr[d]) * kg[d] * qs[wave * 128 + d];
                s = dot * rsk * 0.08838834764831845f;
            }
            sc[r] = s; mx = fmaxf(mx, s);
        }
        mx = wave_max(mx);
        float sum = 0.f;
#pragma unroll
        for (int r = 0; r < 5; ++r) { const float p = __expf(sc[r] - mx); sc[r] = p; sum += p; }
        sum = wave_sum(sum) + __expf(skv - mx);
        const float isum = 1.0f / sum;
#pragma unroll
        for (int r = 0; r < 5; ++r) ps[wave * 320 + lane + 64 * r] = sc[r] * isum;
        __syncthreads();
        float o0 = 0.f, o1 = 0.f;
        for (int jrel = 0; jrel <= 256; ++jrel) { const int kp = pos - 128 + jrel; if (kp < 0 || kp >= SEQ) continue;
            const float p = ps[wave * 320 + jrel]; const bf16_t* vr = Z + (size_t)(b * SEQ + kp) * NIN + C_AV + kvh * 128; o0 += p * bf2f(vr[lane]); o1 += p * bf2f(vr[lane + 64]); }
        const bf16_t* gp = Z + (size_t)t * NIN + C_AG + hq * 128; bf16_t* yp = Yc + (size_t)t * 1024 + hq * 128;
        yp[lane] = f2bf(o0 * bf2f(gp[lane])); yp[lane + 64] = f2bf(o1 * bf2f(gp[lane + 64]));
        __syncthreads();
    }
}

__device__ void pool_naive(const Args& a, int l, float* P) {
    const bf16_t* Z = (const bf16_t*)(a.ws + WS_Z); bf16_t* Yb = (bf16_t*)(a.ws + WS_YB);
    const float* pw = a.in[5] + (size_t)l * 4 * 65536; const float* psc = a.in[6] + l * 1024;
    const int tid = otid();
    for (int tile = blockIdx.x; tile < T_TOK / 16; tile += gridDim.x) {
        const int t0 = tile * 16;
        for (int p = tid; p < 16 * 1024; p += NTHR) {
            const int tt = p >> 10, c = p & 1023, g = c >> 8, hw = 1 << g;
            const int t = t0 + tt, pos = t & (SEQ - 1), bb = t - pos;
            int lo = pos - hw, hi = pos + hw; lo = lo < 0 ? 0 : lo; hi = hi > SEQ ? SEQ : hi;
            float s = 0.f;
            for (int q = lo; q < hi; ++q) s += bf2f(Z[(size_t)(bb + q) * NIN + C_PV + c]);
            P[p] = s / (float)(hi - lo) - bf2f(Z[(size_t)t * NIN + C_PV + c]);
        }
        __syncthreads();
        for (int p = tid; p < 16 * 1024; p += NTHR) {
            const int tt = p >> 10, c = p & 1023, g = c >> 8, e = c & 255;
            const float* pp = P + tt * 1024 + g * 256; const float* wp = pw + (size_t)g * 65536 + e;
            float acc = 0.f;
            for (int d = 0; d < 256; ++d) acc += pp[d] * wp[(size_t)d * 256];
            const int t = t0 + tt;
            Yb[(size_t)t * 1024 + c] = f2bf(acc * psc[c] * bf2f(Z[(size_t)t * NIN + C_PG + c]));
        }
        __syncthreads();
    }
}


typedef short bf16x4 __attribute__((ext_vector_type(4)));
__device__ __forceinline__ f32x4 mfma16(bf16x8 a, bf16x8 b, f32x4 c) { return __builtin_amdgcn_mfma_f32_16x16x32_bf16(a, b, c, 0, 0, 0); }
__device__ __forceinline__ bf16x4 trr(LAS unsigned char* p) { return __builtin_amdgcn_ds_read_tr16_b64_v4i16((LAS bf16x4*)p); }
__device__ __forceinline__ bf16x8 cat8(bf16x4 a, bf16x4 b) { return __builtin_shufflevector(a, b, 0, 1, 2, 3, 4, 5, 6, 7); }
__device__ __forceinline__ bf16x8 pack8(f32x4 a, f32x4 b) { u32x4 w; w.x = cvt_pk_bf16(a[0], a[1]); w.y = cvt_pk_bf16(a[2], a[3]); w.z = cvt_pk_bf16(b[0], b[1]); w.w = cvt_pk_bf16(b[2], b[3]); return __builtin_bit_cast(bf16x8, w); }

__device__ __forceinline__ void pool_item(const Args& a, int l, int it, LAS unsigned char* lds, int tid) {
    const bf16_t* Z = (const bf16_t*)(a.ws + WS_Z); bf16_t* Yb = (bf16_t*)(a.ws + WS_YB);
    const bf16_t* PWt = (const bf16_t*)(a.ws + WS_PW + (size_t)l * SZ_PW); const float* psc = a.in[6] + l * 1024;
    const int lane = tid & 63, wave = tid >> 6, g = it & 3, tile = it >> 2, t0 = tile * 128, hw = 1 << g;
    LAS unsigned char* Us = lds; LAS unsigned char* Ps = lds + 144 * 528;
    {
        const int pos0 = t0 & (SEQ - 1);
#pragma unroll
        for (int i = 0; i < 9; ++i) { const int c = tid + 512 * i, row = c >> 5, ch = c & 31, pos = pos0 - 8 + row;
            int tr = t0 - 8 + row; tr = tr < 0 ? 0 : (tr >= T_TOK ? T_TOK - 1 : tr);
            u32x4 v = *(const u32x4*)(Z + (size_t)tr * NIN + C_PV + g * 256 + ch * 8);
            const unsigned keep = (pos >= 0 && pos < SEQ) ? 0xffffffffu : 0u; v.x &= keep; v.y &= keep; v.z &= keep; v.w &= keep;
            *(LAS u32x4*)(Us + row * 528 + ch * 16) = v; }
    }
    __syncthreads();
    {
        const int c8 = (tid & 31) * 8, rg = tid >> 5, r0 = rg * 8, pos0 = (t0 & (SEQ - 1)) + r0;
        LAS unsigned char* ub = Us + (r0 + 8) * 528 + c8 * 2;
        f32x4 sa = (f32x4){0.f, 0.f, 0.f, 0.f}, sb = (f32x4){0.f, 0.f, 0.f, 0.f};
        for (int j = -hw; j < hw; ++j) { const u32x4 v = *(const LAS u32x4*)(ub + j * 528);
            sa += (f32x4){lo16(v.x), hi16(v.x), lo16(v.y), hi16(v.y)}; sb += (f32x4){lo16(v.z), hi16(v.z), lo16(v.w), hi16(v.w)}; }
#pragma unroll 1
        for (int i = 0; i < 8; ++i) {
            const int pos = pos0 + i; int lo = pos - hw, hi = pos + hw; lo = lo < 0 ? 0 : lo; hi = hi > SEQ ? SEQ : hi;
            const float ic = 1.0f / (float)(hi - lo);
            const u32x4 cv = *(const LAS u32x4*)(ub + i * 528), vin = *(const LAS u32x4*)(ub + (i + hw) * 528), vout = *(const LAS u32x4*)(ub + (i - hw) * 528);
            const f32x4 ca = (f32x4){lo16(cv.x), hi16(cv.x), lo16(cv.y), hi16(cv.y)}, cb = (f32x4){lo16(cv.z), hi16(cv.z), lo16(cv.w), hi16(cv.w)};
            *(LAS bf16x8*)(Ps + (r0 + i) * 528 + c8 * 2) = pack8(sa * ic - ca, sb * ic - cb);
            sa += (f32x4){lo16(vin.x), hi16(vin.x), lo16(vin.y), hi16(vin.y)} - (f32x4){lo16(vout.x), hi16(vout.x), lo16(vout.y), hi16(vout.y)};
            sb += (f32x4){lo16(vin.z), hi16(vin.z), lo16(vin.w), hi16(vin.w)} - (f32x4){lo16(vout.z), hi16(vout.z), lo16(vout.w), hi16(vout.w)};
        }
    }
    __syncthreads();
    const int wr = wave >> 2, wc = wave & 3, fr = lane & 15, fq = lane >> 4;
    f32x4 acc[4][4];
#pragma unroll
    for (int i = 0; i < 4; ++i)
#pragma unroll
        for (int j = 0; j < 4; ++j) acc[i][j] = (f32x4){0.f, 0.f, 0.f, 0.f};
    const bf16_t* Bp = PWt + (size_t)g * 65536 + (size_t)(wc * 64 + fr) * 256 + 8 * fq;
#pragma unroll 1
    for (int kh = 0; kh < 2; ++kh) {
        bf16x8 bfr[4][4];
#pragma unroll
        for (int k4 = 0; k4 < 4; ++k4)
#pragma unroll
            for (int nt = 0; nt < 4; ++nt) bfr[k4][nt] = *(const bf16x8*)(Bp + nt * 16 * 256 + (kh * 4 + k4) * 32);
#pragma unroll
        for (int k4 = 0; k4 < 4; ++k4) {
            bf16x8 af[4];
#pragma unroll
            for (int mt = 0; mt < 4; ++mt) af[mt] = *(const LAS bf16x8*)(Ps + (wr * 64 + mt * 16 + fr) * 528 + ((kh * 4 + k4) * 32 + 8 * fq) * 2);
#pragma unroll
            for (int mt = 0; mt < 4; ++mt)
#pragma unroll
                for (int nt = 0; nt < 4; ++nt) acc[mt][nt] = mfma16(bfr[k4][nt], af[mt], acc[mt][nt]);
        }
    }
    {
        u32x2 gt[4][4]; f32x4 scv[4];
#pragma unroll
        for (int nt = 0; nt < 4; ++nt) scv[nt] = *(const f32x4*)(psc + g * 256 + wc * 64 + nt * 16 + 4 * fq);
#pragma unroll
        for (int mt = 0; mt < 4; ++mt)
#pragma unroll
            for (int nt = 0; nt < 4; ++nt) gt[mt][nt] = *(const u32x2*)(Z + (size_t)(t0 + wr * 64 + mt * 16 + fr) * NIN + C_PG + g * 256 + wc * 64 + nt * 16 + 4 * fq);
#pragma unroll
        for (int mt = 0; mt < 4; ++mt) {
            const int t = t0 + wr * 64 + mt * 16 + fr;
#pragma unroll
            for (int nt = 0; nt < 4; ++nt) {
                const int c = g * 256 + wc * 64 + nt * 16 + 4 * fq;
                const f32x4 v = acc[mt][nt] * scv[nt]; const u32x2 gg = gt[mt][nt];
                u32x2 o; o.x = cvt_pk_bf16(v[0] * lo16(gg.x), v[1] * hi16(gg.x)); o.y = cvt_pk_bf16(v[2] * lo16(gg.y), v[3] * hi16(gg.y));
                *(u32x2*)(Yb + (size_t)t * 1024 + c) = o;
            }
        }
    }
}

#define ATT_CI(i) ((i) == 0 ? 1.591549431e-01f : (i) == 1 ? 7.008652159e-02f : (i) == 2 ? 3.086376340e-02f : (i) == 3 ? 1.359137064e-02f : (i) == 4 ? 5.985185713e-03f : (i) == 5 ? 2.635675899e-03f : \
    (i) == 6 ? 1.160663641e-03f : (i) == 7 ? 5.111175045e-04f : (i) == 8 ? 2.250790790e-04f : (i) == 9 ? 9.911730937e-05f : (i) == 10 ? 4.364795279e-05f : (i) == 11 ? 1.922110068e-05f : \
    (i) == 12 ? 8.464330808e-06f : (i) == 13 ? 3.727408602e-06f : (i) == 14 ? 1.641426263e-06f : 7.228293069e-07f)

__device__ __forceinline__ void attn_item(const Args& a, int l, int it, LAS unsigned char* lds, int tid) {
    const bf16_t* Z = (const bf16_t*)(a.ws + WS_Z); bf16_t* Yc = (bf16_t*)(a.ws + WS_YC);
    const float* cA = (const float*)(a.ws + WS_COSA); const float* sA = (const float*)(a.ws + WS_SINA);
    const float* qg = a.in[7] + l * 128; const float* kg = a.in[8] + l * 128; const float* sink = a.in[9] + l * 8;
    const int lane = tid & 63, wave = tid >> 6, fr = lane & 15, fq = lane >> 4;
    const int half = it & 1, kvh = (it >> 1) & 1, n = (it >> 2) & 31, b = it >> 7;
    const int hq = kvh * 4 + half * 2 + (wave >> 2), qrow0 = (wave & 3) * 32, tq0 = b * SEQ + n * 128;
    LAS unsigned char* Ks = lds; LAS unsigned char* Vs = lds + 128 * 272;
    LAS unsigned char* Qs = lds + 71680 + (wave * 32 + fr) * 272 + 16 * fq;
#pragma unroll
    for (int qt = 0; qt < 2; ++qt) {
        const int qrow = qrow0 + qt * 16 + fr, pos = n * 128 + qrow;
        const bf16_t* qp = Z + (size_t)(tq0 + qrow) * NIN + C_AQ + hq * 128 + 8 * fq;
        f32x4 x[4][2]; float ss = 0.f;
#pragma unroll
        for (int ks = 0; ks < 4; ++ks) { const u32x4 r = *(const u32x4*)(qp + ks * 32);
            x[ks][0] = (f32x4){lo16(r.x), hi16(r.x), lo16(r.y), hi16(r.y)}; x[ks][1] = (f32x4){lo16(r.z), hi16(r.z), lo16(r.w), hi16(r.w)};
            const f32x4 q0 = x[ks][0] * x[ks][0], q1 = x[ks][1] * x[ks][1]; ss += (q0[0] + q0[1]) + (q0[2] + q0[3]) + (q1[0] + q1[1]) + (q1[2] + q1[3]); }
        ss += __shfl_xor(ss, 16); ss += __shfl_xor(ss, 32);
        const float rs = rsqrtf(ss * (1.0f / 128.0f) + 1e-6f) * 0.08838834764831845f;
#pragma unroll
        for (int ks = 0; ks < 4; ++ks) { x[ks][0] *= *(const f32x4*)(qg + ks * 32 + 8 * fq) * rs; x[ks][1] *= *(const f32x4*)(qg + ks * 32 + 8 * fq + 4) * rs; }
        {
            f32x4 c0, c1, s0, s1; const float fp = (float)pos; const bool hi8 = (fq & 1) != 0;
#pragma unroll
            for (int j = 0; j < 4; ++j) { float sa, ca, sb, cb; hw_sincos_rev(fp * (hi8 ? ATT_CI(8 + j) : ATT_CI(j)), sa, ca); hw_sincos_rev(fp * (hi8 ? ATT_CI(12 + j) : ATT_CI(4 + j)), sb, cb); s0[j] = sa; c0[j] = ca; s1[j] = sb; c1[j] = cb; }
            f32x4 p0, p1;
#pragma unroll
            for (int j = 0; j < 4; ++j) { p0[j] = __shfl_xor(x[0][0][j], 32); p1[j] = __shfl_xor(x[0][1][j], 32); }
            const float sg = fq < 2 ? -1.f : 1.f;
            x[0][0] = x[0][0] * c0 + p0 * s0 * sg; x[0][1] = x[0][1] * c1 + p1 * s1 * sg;
        }
#pragma unroll
        for (int ks = 0; ks < 4; ++ks) *(LAS bf16x8*)(Qs + qt * 16 * 272 + ks * 64) = pack8(x[ks][0], x[ks][1]);
    }
    float mrun[2], lsum[2]; f32x4 O[8][2];
    { const float sk = sink[hq]; mrun[0] = sk; mrun[1] = sk; lsum[0] = fq == 0 ? 1.f : 0.f; lsum[1] = lsum[0]; }
#pragma unroll
    for (int dt = 0; dt < 8; ++dt) { O[dt][0] = (f32x4){0.f, 0.f, 0.f, 0.f}; O[dt][1] = (f32x4){0.f, 0.f, 0.f, 0.f}; }
#pragma unroll 1
    for (int j = 0; j < 3; ++j) {
        const int kb = n - 1 + j; if (kb < 0 || kb > 31) continue;
        {
            const int key = tid >> 2, qtr = tid & 3, kpos = kb * 128 + key;
            const bf16_t* kp = Z + (size_t)(b * SEQ + kpos) * NIN + C_AK + kvh * 128 + qtr * 32;
            u32x4 kr[4], vr[4];
#pragma unroll
            for (int i = 0; i < 4; ++i) { kr[i] = *(const u32x4*)(kp + i * 8); vr[i] = *(const u32x4*)(kp + (C_AV - C_AK) + i * 8); }
            f32x4 x[8]; float ss = 0.f;
#pragma unroll
            for (int i = 0; i < 4; ++i) { const u32x4 r = kr[i];
                x[2 * i] = (f32x4){lo16(r.x), hi16(r.x), lo16(r.y), hi16(r.y)}; x[2 * i + 1] = (f32x4){lo16(r.z), hi16(r.z), lo16(r.w), hi16(r.w)};
                const f32x4 q0 = x[2 * i] * x[2 * i], q1 = x[2 * i + 1] * x[2 * i + 1]; ss += (q0[0] + q0[1]) + (q0[2] + q0[3]) + (q1[0] + q1[1]) + (q1[2] + q1[3]); }
            ss += __shfl_xor(ss, 1); ss += __shfl_xor(ss, 2);
            const float rs = rsqrtf(ss * (1.0f / 128.0f) + 1e-6f);
#pragma unroll
            for (int i = 0; i < 8; ++i) x[i] *= *(const f32x4*)(kg + qtr * 32 + 4 * i) * rs;
            if (qtr == 0) {
                const float fp = (float)kpos;
#pragma unroll
                for (int i = 0; i < 4; ++i) { f32x4 c, sn;
#pragma unroll
                    for (int jj = 0; jj < 4; ++jj) { float sa, ca; hw_sincos_rev(fp * ATT_CI(4 * i + jj), sa, ca); sn[jj] = sa; c[jj] = ca; }
                    const f32x4 xa = x[i], xb = x[i + 4]; x[i] = xa * c - xb * sn; x[i + 4] = xb * c + xa * sn; }
            }
#pragma unroll
            for (int i = 0; i < 4; ++i) *(LAS bf16x8*)(Ks + key * 272 + qtr * 64 + i * 16) = pack8(x[2 * i], x[2 * i + 1]);
#pragma unroll
            for (int i = 0; i < 4; ++i) *(LAS u32x4*)(Vs + key * 288 + qtr * 64 + i * 16) = vr[i];
        }
        __syncthreads();
        const int msg = (j == 0) ? 1 : ((j == 2) ? -1 : 0);
        f32x4 S[8][2];
        {
            bf16x8 qfr[2][4];
#pragma unroll
            for (int qt = 0; qt < 2; ++qt)
#pragma unroll
                for (int ks = 0; ks < 4; ++ks) qfr[qt][ks] = *(const LAS bf16x8*)(Qs + qt * 16 * 272 + ks * 64);
#pragma unroll
            for (int kt = 0; kt < 8; ++kt) {
                bf16x8 kf[4];
#pragma unroll
                for (int ks = 0; ks < 4; ++ks) kf[ks] = *(const LAS bf16x8*)(Ks + (kt * 16 + fr) * 272 + (ks * 32 + 8 * fq) * 2);
#pragma unroll
                for (int qt = 0; qt < 2; ++qt) { f32x4 sacc = (f32x4){0.f, 0.f, 0.f, 0.f};
#pragma unroll
                    for (int ks = 0; ks < 4; ++ks) sacc = mfma16(kf[ks], qfr[qt][ks], sacc);
                    S[kt][qt] = sacc; }
            }
        }
#pragma unroll
        for (int qt = 0; qt < 2; ++qt) {
            const int ql = qrow0 + qt * 16 + fr; float mx = mrun[qt];
            int dbase = msg * (4 * fq - ql); asm volatile("" : "+v"(dbase), "+v"(S[7][1]));
#pragma unroll
            for (int kt = 0; kt < 8; ++kt)
#pragma unroll
                for (int r = 0; r < 4; ++r) { const int dd = dbase + msg * (kt * 16 + r); const float pen = (float)min(dd, 0) * 1e30f;
                    const float sv = S[kt][qt][r] + pen; S[kt][qt][r] = sv; mx = fmaxf(mx, sv); }
            mx = fmaxf(mx, __shfl_xor(mx, 16)); mx = fmaxf(mx, __shfl_xor(mx, 32));
            const float alpha = __expf(mrun[qt] - mx); mrun[qt] = mx; float ls = lsum[qt] * alpha;
#pragma unroll
            for (int kt = 0; kt < 8; ++kt)
#pragma unroll
                for (int r = 0; r < 4; ++r) { const float p = __expf(S[kt][qt][r] - mx); S[kt][qt][r] = p; ls += p; }
            lsum[qt] = ls;
#pragma unroll
            for (int dt = 0; dt < 8; ++dt) O[dt][qt] *= alpha;
        }
#pragma unroll
        for (int ks2 = 0; ks2 < 4; ++ks2) {
            bf16x8 pf[2];
#pragma unroll
            for (int qt = 0; qt < 2; ++qt) pf[qt] = pack8(S[2 * ks2][qt], S[2 * ks2 + 1][qt]);
#pragma unroll
            for (int dt = 0; dt < 8; ++dt) {
                LAS unsigned char* vb = Vs + (ks2 * 32 + 4 * fq + (fr >> 2)) * 288 + (dt * 16 + 4 * (lane & 3)) * 2;
                const bf16x8 vf = cat8(trr(vb), trr(vb + 16 * 288));
#pragma unroll
                for (int qt = 0; qt < 2; ++qt) O[dt][qt] = mfma16(vf, pf[qt], O[dt][qt]);
            }
        }
        __syncthreads();
    }
    {
        u32x2 gt[2][8];
#pragma unroll
        for (int qt = 0; qt < 2; ++qt)
#pragma unroll
            for (int dt = 0; dt < 8; ++dt) gt[qt][dt] = *(const u32x2*)(Z + (size_t)(tq0 + qrow0 + qt * 16 + fr) * NIN + C_AG + hq * 128 + dt * 16 + 4 * fq);
#pragma unroll
        for (int qt = 0; qt < 2; ++qt) {
            float ls = lsum[qt]; ls += __shfl_xor(ls, 16); ls += __shfl_xor(ls, 32);
            const float inv = 1.0f / ls; const int t = tq0 + qrow0 + qt * 16 + fr;
#pragma unroll
            for (int dt = 0; dt < 8; ++dt) {
                const int c = hq * 128 + dt * 16 + 4 * fq;
                const u32x2 gg = gt[qt][dt]; const f32x4 v = O[dt][qt] * inv;
                u32x2 o; o.x = cvt_pk_bf16(v[0] * lo16(gg.x), v[1] * hi16(gg.x)); o.y = cvt_pk_bf16(v[2] * lo16(gg.y), v[3] * hi16(gg.y));
                *(u32x2*)(Yc + (size_t)t * 1024 + c) = o;
            }
        }
    }
}

__device__ __forceinline__ void scan_item(const Args& a, int l, int it, LAS unsigned char* lds, int tid) {
    const bf16_t* Z = (const bf16_t*)(a.ws + WS_Z);
    const int lane = tid & 63, wave = tid >> 6, fr = lane & 15, fq = lane >> 4;
    const int dsl = it & 3, dir = (it >> 2) & 1, bh = it >> 3, b = bh >> 2, h = bh & 3;
    bf16_t* ST = (bf16_t*)(a.ws + (dir ? WS_SB : WS_SF)) + (size_t)bh * 32 * 65536;
    const float lg = -expf(a.in[dir ? 4 : 3][l * 4 + h]); const float dec = expf(lg * 128.f);
    LAS unsigned char* Ks = lds; LAS unsigned char* Vs = lds + 20480;
    f32x4 st[4][2];
#pragma unroll
    for (int dt = 0; dt < 4; ++dt) { st[dt][0] = (f32x4){0.f, 0.f, 0.f, 0.f}; st[dt][1] = (f32x4){0.f, 0.f, 0.f, 0.f}; }
    u32x4 vrA[8], krA[2], vrB[8], krB[2];
    const bf16_t* zb = Z + (size_t)(b * SEQ) * NIN + h * 256;
#define SCAN_LOAD(vreg, kreg, nn) do { const bf16_t* zc = zb + (size_t)((nn) * 128) * NIN; \
        _Pragma("unroll") for (int i = 0; i < 8; ++i) { const int c = tid + 512 * i; vreg[i] = *(const u32x4*)(zc + (size_t)(c >> 5) * NIN + C_RV + (c & 31) * 8); } \
        _Pragma("unroll") for (int i = 0; i < 2; ++i) { const int c = tid + 512 * i; kreg[i] = *(const u32x4*)(zc + (size_t)(c >> 3) * NIN + C_RK + dsl * 64 + (c & 7) * 8); } } while (0)
#define SCAN_STEP(vreg, kreg, step) do { \
        const int n = dir ? 31 - (step) : (step); \
        _Pragma("unroll") for (int i = 0; i < 8; ++i) { const int c = tid + 512 * i; *(LAS u32x4*)(Vs + (c >> 5) * 544 + (c & 31) * 16) = vreg[i]; } \
        _Pragma("unroll") for (int i = 0; i < 2; ++i) { const int c = tid + 512 * i, row = c >> 3; const float w = dir ? __expf(lg * (float)row) : __expf(lg * (float)(127 - row)); \
            const u32x4 r = kreg[i]; u32x4 o; o.x = cvt_pk_bf16(lo16(r.x) * w, hi16(r.x) * w); o.y = cvt_pk_bf16(lo16(r.y) * w, hi16(r.y) * w); o.z = cvt_pk_bf16(lo16(r.z) * w, hi16(r.z) * w); o.w = cvt_pk_bf16(lo16(r.w) * w, hi16(r.w) * w); \
            *(LAS u32x4*)(Ks + row * 160 + (c & 7) * 16) = o; } \
        __syncthreads(); \
        if ((step) + 2 < 32) SCAN_LOAD(vreg, kreg, dir ? 29 - (step) : (step) + 2); \
        bf16_t* so = ST + (size_t)n * 65536; \
        _Pragma("unroll") for (int dt = 0; dt < 4; ++dt) \
            _Pragma("unroll") for (int e2 = 0; e2 < 2; ++e2) { const int e = (2 * wave + e2) * 16 + fr, d = dsl * 64 + dt * 16 + 4 * fq; const f32x4 v = st[dt][e2]; \
                u32x2 o; o.x = cvt_pk_bf16(v[0], v[1]); o.y = cvt_pk_bf16(v[2], v[3]); *(u32x2*)(so + (size_t)e * 256 + d) = o; st[dt][e2] = v * dec; } \
        _Pragma("unroll") for (int ks2 = 0; ks2 < 4; ++ks2) { \
            const int krow = ks2 * 32 + 4 * fq + (fr >> 2); \
            bf16x8 af[4], bfr[2]; \
            _Pragma("unroll") for (int dt = 0; dt < 4; ++dt) { LAS unsigned char* p = Ks + krow * 160 + (dt * 16 + 4 * (lane & 3)) * 2; af[dt] = cat8(trr(p), trr(p + 16 * 160)); } \
            _Pragma("unroll") for (int e2 = 0; e2 < 2; ++e2) { LAS unsigned char* p = Vs + krow * 544 + ((2 * wave + e2) * 16 + 4 * (lane & 3)) * 2; bfr[e2] = cat8(trr(p), trr(p + 16 * 544)); } \
            _Pragma("unroll") for (int dt = 0; dt < 4; ++dt) \
                _Pragma("unroll") for (int e2 = 0; e2 < 2; ++e2) st[dt][e2] = mfma16(af[dt], bfr[e2], st[dt][e2]); } \
        __syncthreads(); } while (0)
    SCAN_LOAD(vrA, krA, dir ? 31 : 0);
    SCAN_LOAD(vrB, krB, dir ? 30 : 1);
#pragma unroll 1
    for (int step = 0; step < 32; step += 2) {
        SCAN_STEP(vrA, krA, step);
        SCAN_STEP(vrB, krB, step + 1);
    }
#undef SCAN_STEP
#undef SCAN_LOAD
}

__device__ __forceinline__ void rout_item(const Args& a, int l, int it, LAS unsigned char* lds, int tid) {
    const bf16_t* Z = (const bf16_t*)(a.ws + WS_Z); bf16_t* Ya = (bf16_t*)(a.ws + WS_YA);
    const int lane = tid & 63, wave = tid >> 6, fr = lane & 15, fq = lane >> 4;
    const int b = it >> 7, n = (it >> 2) & 31, h = it & 3, bh = b * 4 + h, t0 = b * SEQ + n * 128;
    const float lgf = -expf(a.in[3][l * 4 + h]), lgb = -expf(a.in[4][l * 4 + h]);
    LAS unsigned char* Ks = lds; LAS unsigned char* Vs = lds + 128 * 528;
#pragma unroll 1
    for (int i4 = 0; i4 < 2; ++i4) {
        u32x4 kr[4], vr[4];
#pragma unroll
        for (int i = 0; i < 4; ++i) { const int c = tid + 512 * (i4 * 4 + i), row = c >> 5, ch = c & 31; const bf16_t* zp = Z + (size_t)(t0 + row) * NIN + h * 256 + ch * 8;
            kr[i] = *(const u32x4*)(zp + C_RK); vr[i] = *(const u32x4*)(zp + C_RV); }
#pragma unroll
        for (int i = 0; i < 4; ++i) { const int c = tid + 512 * (i4 * 4 + i), row = c >> 5, ch = c & 31;
            *(LAS u32x4*)(Ks + row * 528 + ch * 16) = kr[i]; *(LAS u32x4*)(Vs + row * 544 + ch * 16) = vr[i]; }
    }
    const int jq = wave * 16 + fr;
    bf16x8 qf[8];
#pragma unroll
    for (int ks = 0; ks < 8; ++ks) qf[ks] = *(const bf16x8*)(Z + (size_t)(t0 + jq) * NIN + C_RQ + h * 256 + ks * 32 + 8 * fq);
    __syncthreads();
    f32x4 S[8];
#pragma unroll
    for (int kt = 0; kt < 8; ++kt) { f32x4 sacc = (f32x4){0.f, 0.f, 0.f, 0.f};
#pragma unroll
        for (int ks = 0; ks < 8; ++ks) sacc = mfma16(*(const LAS bf16x8*)(Ks + (kt * 16 + fr) * 528 + (ks * 32 + 8 * fq) * 2), qf[ks], sacc);
        S[kt] = sacc; }
    {
        int lb = jq - 4 * fq; asm volatile("" : "+v"(lb), "+v"(S[7]));
#pragma unroll
        for (int kt = 0; kt < 8; ++kt)
#pragma unroll
            for (int r = 0; r < 4; ++r) { const float fl = (float)(lb - (kt * 16 + r)); S[kt][r] *= __expf(fmaxf(fl, 0.f) * lgf + fmaxf(-fl, 0.f) * lgb); }
    }
    f32x4 O[16];
#pragma unroll
    for (int dt = 0; dt < 16; ++dt) O[dt] = (f32x4){0.f, 0.f, 0.f, 0.f};
#pragma unroll
    for (int ks2 = 0; ks2 < 4; ++ks2) {
        const bf16x8 pf = pack8(S[2 * ks2], S[2 * ks2 + 1]);
#pragma unroll
        for (int dt = 0; dt < 16; ++dt) { LAS unsigned char* vb = Vs + (ks2 * 32 + 4 * fq + (fr >> 2)) * 544 + (dt * 16 + 4 * (lane & 3)) * 2;
            O[dt] = mfma16(cat8(trr(vb), trr(vb + 16 * 544)), pf, O[dt]); if ((dt & 3) == 3) asm volatile("" ::: "memory"); }
    }
    bf16x8 qf2[8];
    { const bf16_t* qp2 = Z + (size_t)(t0 + jq) * NIN + C_RQ + h * 256 + 8 * fq; asm volatile("" : "+v"(qp2));
#pragma unroll
      for (int ks = 0; ks < 8; ++ks) qf2[ks] = *(const bf16x8*)(qp2 + ks * 32); }
    __syncthreads();
#pragma unroll 1
    for (int dir = 0; dir < 2; ++dir) {
        if ((dir == 0 && n == 0) || (dir == 1 && n == 31)) continue;
        const bf16_t* ST = (const bf16_t*)(a.ws + (dir ? WS_SB : WS_SF)) + ((size_t)bh * 32 + n) * 65536;
#pragma unroll 1
        for (int hh = 0; hh < 2; ++hh) {
            u32x4 sreg[8];
#pragma unroll
            for (int i = 0; i < 8; ++i) { const int c = tid + 512 * (i + 8 * hh); sreg[i] = *(const u32x4*)(ST + (size_t)(c >> 5) * 256 + (c & 31) * 8); }
#pragma unroll
            for (int i = 0; i < 8; ++i) { const int c = tid + 512 * (i + 8 * hh); *(LAS u32x4*)(lds + (c >> 5) * 528 + (c & 31) * 16) = sreg[i]; }
        }
        __syncthreads();
        const float sc = dir ? __expf(lgb * (float)(128 - jq)) : __expf(lgf * (float)(jq + 1));
#pragma unroll
        for (int dt = 0; dt < 16; ++dt) { f32x4 tacc = (f32x4){0.f, 0.f, 0.f, 0.f};
#pragma unroll
            for (int ks = 0; ks < 8; ++ks) tacc = mfma16(*(const LAS bf16x8*)(lds + (dt * 16 + fr) * 528 + (ks * 32 + 8 * fq) * 2), qf2[ks], tacc);
            O[dt] += tacc * sc; }
        __syncthreads();
    }
    float ss = 0.f;
#pragma unroll
    for (int dt = 0; dt < 16; ++dt) { const f32x4 q = O[dt] * O[dt]; ss += (q[0] + q[1]) + (q[2] + q[3]); }
    ss += __shfl_xor(ss, 16); ss += __shfl_xor(ss, 32);
    const float rs = rsqrtf(ss * (1.0f / 256.0f) + 1e-6f);
    {
        u32x2 gt[16];
#pragma unroll
        for (int dt = 0; dt < 16; ++dt) gt[dt] = *(const u32x2*)(Z + (size_t)(t0 + jq) * NIN + C_RG + h * 256 + dt * 16 + 4 * fq);
#pragma unroll
        for (int dt = 0; dt < 16; ++dt) { const int c = h * 256 + dt * 16 + 4 * fq; const u32x2 gg = gt[dt]; const f32x4 v = O[dt] * rs;
            u32x2 o; o.x = cvt_pk_bf16(v[0] * lo16(gg.x), v[1] * hi16(gg.x)); o.y = cvt_pk_bf16(v[2] * lo16(gg.y), v[3] * hi16(gg.y));
            *(u32x2*)(Ya + (size_t)(t0 + jq) * 1024 + c) = o; }
    }
}

__device__ __forceinline__ int next_item(unsigned* ctr, LAS int* slot, int tid) {
    __syncthreads();
    if (tid == 0) *slot = (int)atomicAdd(ctr, 1u);
    __syncthreads();
    return *slot;
}
__device__ void mix1_fast(const Args& a, int l, LAS unsigned char* lds, int cofs) {
    unsigned* ctr = (unsigned*)(a.ws + WS_CTR) + cofs + l * 4;
    LAS int* slot = (LAS int*)(lds + LDS_BYTES - 16);
#if PROBE_DUP & 256
    { const int tid = otid(); for (;;) { const int it = next_item(ctr, slot, tid); if (it >= 256) break; scan_item(a, l, it & 127, lds, tid); } }
#else
    { const int tid = otid(); for (;;) { const int it = next_item(ctr, slot, tid); if (it >= 128) break; scan_item(a, l, it, lds, tid); } }
#endif
#if PROBE_DUP & 512
    { const int tid = otid(); for (;;) { const int it = next_item(ctr + 1, slot, tid); if (it >= 1024) break; attn_item(a, l, it & 511, lds, tid); } }
#else
    { const int tid = otid(); for (;;) { const int it = next_item(ctr + 1, slot, tid); if (it >= 512) break; attn_item(a, l, it, lds, tid); } }
#endif
    { const int tid = otid(); for (;;) { const int it = next_item(ctr + 2, slot, tid); if (it >= 512) break; pool_item(a, l, it, lds, tid); } }
}
__device__ void rout_fast(const Args& a, int l, LAS unsigned char* lds, int cofs) {
    const int tid = otid();
    unsigned* ctr = (unsigned*)(a.ws + WS_CTR) + cofs + l * 4 + 3;
    LAS int* slot = (LAS int*)(lds + LDS_BYTES - 16);
    for (;;) {
        const int it = next_item(ctr, slot, tid);
        if (it >= 512) break;
        rout_item(a, l, it, lds, tid);
    }
}


#define XB_TMO      128
#define XB_XCNT(j)  (256  + 64 * (j))
#define XB_XSUB(j)  (1280 + 64 * (j))
#define XB_XGEN(j)  (2304 + 64 * (j))
#define XB_TOP      3328
#define XB_TOPGEN   3392
#define XCD_BAR_WORDS 3456
#define XB_SPIN_CAP (1u << 18)
__device__ __forceinline__ unsigned xb_ld(unsigned* p)              { return __hip_atomic_load(p, __ATOMIC_RELAXED, __HIP_MEMORY_SCOPE_AGENT); }
__device__ __forceinline__ unsigned xb_add(unsigned* p, unsigned v) { return __hip_atomic_fetch_add(p, v, __ATOMIC_RELAXED, __HIP_MEMORY_SCOPE_AGENT); }
__device__ __forceinline__ unsigned xb_xcc_id() { return (unsigned)__builtin_amdgcn_s_getreg((3 << 11) | 20) & 0xFu; }
#define XB_SPIN(cond, bar) do { unsigned _sp = 0; while (cond) { __builtin_amdgcn_s_sleep(1); \
    if ((++_sp & 255u) == 0u) { if (xb_ld(&(bar)[XB_TMO])) break; if (_sp > XB_SPIN_CAP) { atomicAdd(&(bar)[XB_TMO], 1u); break; } } } } while (0)
struct XcdBarrier { unsigned* bar; unsigned x; volatile LAS unsigned* st; };
__device__ __forceinline__ XcdBarrier xcd_barrier_post(unsigned* bar, volatile LAS unsigned* st) {
    XcdBarrier b; b.bar = bar; b.x = xb_xcc_id(); b.st = st;
    if (otid() == 0) (void)xb_add(&bar[XB_XCNT(b.x)], 1u);
    return b;
}
__device__ __forceinline__ void xcd_barrier_complete(unsigned* bar, unsigned x, unsigned& nloc, unsigned& nx) {
    const unsigned G = gridDim.x * gridDim.y * gridDim.z;
    unsigned sum, cnt, mine, sp = 0u;
    for (;;) {
        sum = 0u; cnt = 0u; mine = 0u;
#pragma unroll
        for (unsigned j = 0; j < 16; ++j) { const unsigned c = xb_ld(&bar[XB_XCNT(j)]); sum += c; cnt += (c > 0u) ? 1u : 0u; mine = (j == x) ? c : mine; }
        if (sum == G) break;
        __builtin_amdgcn_s_sleep(1);
        if ((++sp & 255u) == 0u) { if (xb_ld(&bar[XB_TMO])) break; if (sp > XB_SPIN_CAP) { atomicAdd(&bar[XB_TMO], 1u); break; } }
    }
    nloc = mine > 0u ? mine : 1u; nx = cnt > 0u ? cnt : 1u;
}
__device__ __forceinline__ void xcd_barrier(const XcdBarrier& b) {
    asm volatile("s_waitcnt vmcnt(0)" ::: "memory");
    __syncthreads();
    if (otid() == 0) {
        unsigned* bar = b.bar;
        __builtin_amdgcn_s_waitcnt(0);
        unsigned nloc = b.st[0], nx = b.st[1];
        if (nloc == 0u) { xcd_barrier_complete(bar, b.x, nloc, nx); b.st[0] = nloc; b.st[1] = nx; }
        const unsigned old = xb_add(&bar[XB_XSUB(b.x)], 1u);
        const unsigned gen = old / nloc;
        if (old + 1u == (gen + 1u) * nloc) {
            __builtin_amdgcn_fence(__ATOMIC_RELEASE, "agent");
            asm volatile("s_waitcnt vmcnt(0)" ::: "memory");
            const unsigned og = xb_add(&bar[XB_TOP], 1u);
            const unsigned tg = og / nx;
            if (og + 1u == (tg + 1u) * nx) xb_add(&bar[XB_TOPGEN], 1u);
            else XB_SPIN(xb_ld(&bar[XB_TOPGEN]) == tg, bar);
            __builtin_amdgcn_fence(__ATOMIC_ACQUIRE, "agent");
            xb_add(&bar[XB_XGEN(b.x)], 1u);
            asm volatile("s_waitcnt vmcnt(0)" ::: "memory");
        } else {
            XB_SPIN(xb_ld(&bar[XB_XGEN(b.x)]) == gen, bar);
            __builtin_amdgcn_fence(__ATOMIC_ACQUIRE, "agent");
            asm volatile("s_waitcnt vmcnt(0)" ::: "memory");
        }
    }
    __syncthreads();
}

__device__ __forceinline__ void class_barrier(unsigned* cls, unsigned target) {
    asm volatile("s_waitcnt vmcnt(0)" ::: "memory");
    __syncthreads();
    if (otid() == 0) {
        unsigned* p = cls + (blockIdx.x & 7) * 64;
        (void)__hip_atomic_fetch_add(p, 1u, __ATOMIC_RELAXED, __HIP_MEMORY_SCOPE_AGENT);
        while (__hip_atomic_load(p, __ATOMIC_RELAXED, __HIP_MEMORY_SCOPE_AGENT) < target) __builtin_amdgcn_s_sleep(1);
        __builtin_amdgcn_fence(__ATOMIC_ACQUIRE, "agent");
        asm volatile("s_waitcnt vmcnt(0)" ::: "memory");
    }
    __syncthreads();
}

constexpr int N_PHASES = 1 + 5 * DEPTH;

__global__ void __launch_bounds__(NTHR, 2) mk_fwd(Args a) {
    extern __shared__ __attribute__((aligned(16))) unsigned char lds_raw[];
    LAS unsigned char* lds = (LAS unsigned char*)lds_raw;
    float* ldsf = (float*)lds_raw;
    unsigned char* ws = a.ws;
    const int lo = a.ph_lo, hi = a.ph_hi;
#ifndef PHMASK
#define PHMASK 0xff
#endif
#define IN(k) (lo <= (k) && (k) < hi)
    volatile LAS unsigned* xst = (volatile LAS unsigned*)(lds + LDS_BYTES - 32);
    if (threadIdx.x < 2) xst[threadIdx.x] = 0u;
    if ((threadIdx.x & 63) == 0) *(LAS int*)(lds + WTAB_OFF + ((unsigned)__builtin_amdgcn_s_getreg((5 << 11) | 4) & 63u) * 4) = (int)(threadIdx.x >> 6);
    __syncthreads();
#define SEAM(k) do { if (IN(k) && IN((k) + 1)) { if ((k) == 0) { cg::this_grid().sync(); (void)xcd_barrier_post((unsigned*)(a.ws + WS_BAR), xst); } else { XcdBarrier xb_; xb_.bar = (unsigned*)(a.ws + WS_BAR); xb_.x = xb_xcc_id(); xb_.st = xst; xcd_barrier(xb_); } } } while (0)
    if ((PHMASK & 1) && IN(0)) { prologue(a, ldsf);
#if PROBE_DUP & 1
        prologue(a, ldsf);
#endif
    }
    SEAM(0);
    if (otid() == 0 && (xb_xcc_id() & 7u) != (blockIdx.x & 7u)) atomicAdd((unsigned*)(a.ws + WS_BAR) + 4090, 1u);
    { XcdBarrier xb_; xb_.bar = (unsigned*)(a.ws + WS_BAR); xb_.x = xb_xcc_id(); xb_.st = xst; xcd_barrier(xb_); }
    unsigned cls_gen = 0u;
    const bool cls_ok = ((gridDim.x & 7u) == 0u) && (__builtin_amdgcn_readfirstlane((int)__hip_atomic_load((unsigned*)(a.ws + WS_BAR) + 4090, __ATOMIC_RELAXED, __HIP_MEMORY_SCOPE_AGENT)) == 0);
#define SEAM_CLS(k) do { if (IN(k) && IN((k) + 1)) { if (cls_ok) { ++cls_gen; class_barrier((unsigned*)(a.ws + WS_BAR) + 3584, cls_gen * (gridDim.x >> 3)); } else { XcdBarrier xb_; xb_.bar = (unsigned*)(a.ws + WS_BAR); xb_.x = xb_xcc_id(); xb_.st = xst; xcd_barrier(xb_); } } } while (0)
    for (int l = 0; l < DEPTH; ++l) {
        const int pb = 1 + 5 * l;
        if ((PHMASK & 2) && IN(pb)) {
            int pm0, pn0_; pg8::tile_order((long)blockIdx.x, T_TOK / 256, NIN / 256, pm0, pn0_);
            LAS float* rsl = (LAS float*)(lds + 131072);
            {
                const int t = otid();
                if (t < 256) { const f32x4* rp = (const f32x4*)((const float*)(ws + WS_ROWSS) + (size_t)(pm0 * 256 + t) * 32);
                    f32x4 p[8];
#pragma unroll
                    for (int q = 0; q < 8; ++q) p[q] = rp[q];
                    float sk[4];
#pragma unroll
                    for (int q = 0; q < 4; ++q) { const f32x4 t4 = p[2 * q] + p[2 * q + 1]; sk[q] = (t4[0] + t4[1]) + (t4[2] + t4[3]); }
                    rsl[t] = rsqrtf(((sk[0] + sk[1]) + (sk[2] + sk[3])) * (1.0f / DM) + 1e-6f); }
                __syncthreads();
            }
            InProj S{(const bf16_t*)(ws + WS_XB), (const bf16_t*)(ws + WS_WIN + l * SZ_WIN), (bf16_t*)(ws + WS_Z), (const float*)(ws + WS_ROWSS),
                     (const float*)(ws + WS_COSR), (const float*)(ws + WS_SINR), (int)gridDim.x, (int)blockIdx.x, pm0, rsl};
            pg8::gemm_phase<InProj>(lds, DM, S);
#if PROBE_DUP & 8
            pg8::gemm_phase<InProj>(lds, DM, S);
#endif
        }
        SEAM(pb);
        if (IN(pb + 1)) {
#if FAST_MIX
            if (PHMASK & 4) mix1_fast(a, l, lds, 0);
#if PROBE_DUP & 2
            mix1_fast(a, l, lds, 32);
#endif
#else
            if (PHMASK & 4) ret_scan_naive(a, l);
            if (PHMASK & 8) attn_naive(a, l, ldsf);
            if (PHMASK & 16) pool_naive(a, l, ldsf);
#endif
        }
        SEAM(pb + 1);
        #if FAST_ROUT
        if ((PHMASK & 32) && IN(pb + 2)) { rout_fast(a, l, lds, 0);
#if PROBE_DUP & 4
            rout_fast(a, l, lds, 32);
#endif
        }
#else
        if ((PHMASK & 32) && IN(pb + 2)) { ret_out_naive(a, l, ldsf); }
#endif
        SEAM(pb + 2);
        if ((PHMASK & 64) && IN(pb + 3)) {
            MergeP S{(const bf16_t*)(ws + WS_YA), (const bf16_t*)(ws + WS_WRET + l * SZ_WBR),
                     (const bf16_t*)(ws + WS_Z), (bf16_t*)(ws + WS_MG), (int)gridDim.x, (int)blockIdx.x};
            pg8::gemm_phase<MergeP>(lds, 1024, S);
#if PROBE_DUP & 16
            pg8::gemm_phase<MergeP>(lds, 1024, S);
#endif
        }
        SEAM_CLS(pb + 3);
        if ((PHMASK & 128) && IN(pb + 4)) {
            OutProj S{(const bf16_t*)(ws + WS_MG), (const bf16_t*)(ws + WS_WOUT + l * SZ_WOUT), l == 0 ? a.in[0] : a.out, a.out, (bf16_t*)(ws + WS_XB),
                      l + 1 < DEPTH ? (float*)(ws + WS_ROWSS) : nullptr, (int)gridDim.x, (int)blockIdx.x};
            pg8::gemm_phase<OutProj>(lds, DM, S);
#if PROBE_DUP & 64
            if (l == 0) { pg8::gemm_phase<OutProj>(lds, DM, S); pg8::gemm_phase<OutProj>(lds, DM, S); }
#endif
        }
        SEAM_CLS(pb + 4);
    }
#undef IN
#undef SEAM
}

extern "C" void kernel_launch(void* const* d_in, const int* in_sizes, int n_in, void* d_out, int out_size, void* d_ws, size_t ws_size, hipStream_t stream) {
    static int grid = 0;
    if (grid == 0) {
        if (n_in != 14 || out_size != T_TOK * DM || ws_size < WS_END) { fprintf(stderr, "kernel_launch: unexpected shapes (n_in %d out %d ws %zu need %zu)\n", n_in, out_size, ws_size, (size_t)WS_END); grid = -1; return; }
        int dev = 0, cus = 0, per_cu = 0;
        hipGetDevice(&dev); hipDeviceGetAttribute(&cus, hipDeviceAttributeMultiprocessorCount, dev);
        if (hipFuncSetAttribute((const void*)mk_fwd, hipFuncAttributeMaxDynamicSharedMemorySize, LDS_BYTES) != hipSuccess) { fprintf(stderr, "kernel_launch: hipFuncSetAttribute failed\n"); grid = -1; return; }
        if (hipOccupancyMaxActiveBlocksPerMultiprocessor(&per_cu, (const void*)mk_fwd, NTHR, LDS_BYTES) != hipSuccess || per_cu < 1) { fprintf(stderr, "kernel_launch: occupancy query says %d\n", per_cu); per_cu = 1; }
        (void)hipGetLastError();
        grid = cus * 1;
    }
    if (grid < 0) return;
    Args a{};
    for (int i = 0; i < 14; ++i) a.in[i] = (const float*)d_in[i];
    a.out = (float*)d_out; a.ws = (unsigned char*)d_ws;
#if ONE_LAUNCH
    a.ph_lo = 0; a.ph_hi = N_PHASES;
    void* args[] = {&a};
    hipError_t e = hipLaunchCooperativeKernel((const void*)mk_fwd, dim3(grid), dim3(NTHR), args, LDS_BYTES, stream);
    if (e != hipSuccess) fprintf(stderr, "cooperative launch failed: %s (grid %d)\n", hipGetErrorString(e), grid);
#else
    for (int p = 0; p < N_PHASES; ++p) {
        a.ph_lo = p; a.ph_hi = p + 1;
        hipLaunchKernelGGL(mk_fwd, dim3(grid), dim3(NTHR), LDS_BYTES, stream, a);
    }
#endif
}
```

```cpp
#include <hip/hip_runtime.h>
#include <hip/hip_cooperative_groups.h>
#include <cstdio>
namespace cg = cooperative_groups;

#ifndef FAST_MIX
#define FAST_MIX 1
#endif
#ifndef FAST_ROUT
#define FAST_ROUT 1
#endif
#ifndef PROBE_DUP
#define PROBE_DUP 0
#endif
#ifndef ONE_LAUNCH
#define ONE_LAUNCH 1
#endif

#define LAS __attribute__((address_space(3)))
typedef unsigned short bf16_t;
typedef short bf16x8 __attribute__((ext_vector_type(8)));
typedef float f32x4 __attribute__((ext_vector_type(4)));
typedef unsigned u32x4 __attribute__((ext_vector_type(4)));
typedef unsigned u32x2 __attribute__((ext_vector_type(2)));

constexpr int T_TOK = 16384, DM = 2048, NIN = 14848, SEQ = 4096, DEPTH = 4;
constexpr int C_RQ = 0, C_RK = 1024, C_RV = 2048, C_RG = 3072, C_PV = 4096, C_PG = 5120, C_AQ = 6144, C_AK = 7168, C_AV = 7424, C_AG = 7680, C_MG = 8704;
constexpr int NTHR = 512;
constexpr int LDS_BYTES = 147456;

constexpr size_t SZ_WIN = (size_t)NIN * DM * 2, SZ_WBR = (size_t)DM * 1024 * 2, SZ_WOUT = (size_t)DM * DM * 2, SZ_PW = (size_t)4 * 256 * 256 * 2;
constexpr size_t WS_WIN = 0;
constexpr size_t WS_WRET = WS_WIN + DEPTH * SZ_WIN;
constexpr size_t WS_WPOOL = WS_WRET + DEPTH * SZ_WBR;
constexpr size_t WS_WATT = WS_WPOOL + DEPTH * SZ_WBR;
constexpr size_t WS_WOUT = WS_WATT + DEPTH * SZ_WBR;
constexpr size_t WS_PW = WS_WOUT + DEPTH * SZ_WOUT;
constexpr size_t WS_XB = WS_PW + DEPTH * SZ_PW;
constexpr size_t WS_Z = WS_XB + (size_t)T_TOK * DM * 2;
constexpr size_t WS_ROWSS = WS_Z + (size_t)T_TOK * NIN * 2;
constexpr size_t WS_SF = WS_ROWSS + (size_t)T_TOK * 32 * 4;
constexpr size_t SZ_ST = (size_t)16 * 32 * 65536 * 2;
constexpr size_t WS_SB = WS_SF + SZ_ST;
constexpr size_t WS_YA = WS_SB + SZ_ST;
constexpr size_t SZ_Y = (size_t)T_TOK * 1024 * 2;
constexpr size_t WS_YB = WS_YA + SZ_Y;
constexpr size_t WS_YC = WS_YB + SZ_Y;
constexpr size_t WS_MG = WS_YC + SZ_Y;
constexpr size_t WS_COSR = WS_MG + (size_t)T_TOK * DM * 2;
constexpr size_t WS_SINR = WS_COSR + (size_t)SEQ * 128 * 4;
constexpr size_t WS_COSA = WS_SINR + (size_t)SEQ * 128 * 4;
constexpr size_t WS_SINA = WS_COSA + (size_t)SEQ * 16 * 4;
constexpr size_t WS_CTR = WS_SINA + (size_t)SEQ * 16 * 4;
constexpr size_t WS_BAR = WS_CTR + 256;
constexpr size_t WS_END = WS_BAR + 16384;

struct Args { const float* in[14]; float* out; unsigned char* ws; int ph_lo, ph_hi; };

__device__ __forceinline__ float bf2f(bf16_t b) { return __uint_as_float(((unsigned)b) << 16); }
__device__ __forceinline__ unsigned cvt_pk_bf16(float lo, float hi) { unsigned r; asm volatile("v_cvt_pk_bf16_f32 %0, %1, %2" : "=v"(r) : "v"(lo), "v"(hi)); return r; }
__device__ __forceinline__ bf16_t f2bf(float f) { return (bf16_t)(cvt_pk_bf16(f, 0.f) & 0xffffu); }
__device__ __forceinline__ float lo16(unsigned w) { return __uint_as_float(w << 16); }
__device__ __forceinline__ float hi16(unsigned w) { return __uint_as_float(w & 0xffff0000u); }
__device__ __forceinline__ float wave_sum(float v) {
#pragma unroll
    for (int o = 32; o >= 1; o >>= 1) v += __shfl_xor(v, o);
    return v;
}
__device__ __forceinline__ float wave_max(float v) {
#pragma unroll
    for (int o = 32; o >= 1; o >>= 1) v = fmaxf(v, __shfl_xor(v, o));
    return v;
}
__device__ __forceinline__ int otid() { int t = threadIdx.x; asm volatile("" : "+v"(t)); return t; }
__device__ __forceinline__ void hw_sincos_rev(float rev, float& sn, float& cs) { const float f = __builtin_amdgcn_fractf(rev); sn = __builtin_amdgcn_sinf(f); cs = __builtin_amdgcn_cosf(f); }
__device__ __forceinline__ float silu_f(float v) { return v * __builtin_amdgcn_rcpf(1.f + __expf(-v)); }
__device__ __forceinline__ float sigm_f(float v) { return __builtin_amdgcn_rcpf(1.f + __expf(-v)); }
__device__ __forceinline__ void sincos_red(float ang, float& s, float& c) {
    const double a = (double)ang; const double k = rint(a * 0.15915494309189535); const float r = (float)(a - k * 6.283185307179586);
    s = sinf(r); c = cosf(r);
}

namespace pg8 {
constexpr int BM = 256, BK = 64, HALF = 128, HTB = HALF * BK * 2, STAGE_BYTES = 8 * HTB, NXCD = 8, WGM = 8;
__device__ __forceinline__ int lds_byte(int r, int c) { const int st = (r >> 4) * 2 + (c >> 5), rr = r & 15, cc = c & 31, ob = rr * 64 + cc * 2; return st * 1024 + (ob ^ (((ob >> 9) & 1) << 5)); }
__device__ __forceinline__ void stage_rc(int b, int& R, int& C) { const int st = b / 1024, sb = b % 1024, swz = sb ^ (((sb >> 9) & 1) << 5); R = (st >> 1) * 16 + swz / 64; C = (st & 1) * 32 + (swz % 64) / 2; }
__device__ __forceinline__ int perm32(int rho) { const int n = rho >> 4, i = rho & 15; return 8 * (i >> 2) + 4 * n + (i & 3); }
struct Unit { const char* a; const char* b; int pm, pn, sub; };
__device__ __forceinline__ bool tile_order(long L, int nM, int nN, int& pm, int& pn) {
    const int nwg = nM * nN; if (L >= nwg) return false;
    int wgid = (int)L; { const int q = nwg / NXCD, r = nwg % NXCD, xcd = wgid % NXCD, off = wgid / NXCD; wgid = (xcd < r ? xcd * (q + 1) : r * (q + 1) + (xcd - r) * q) + off; }
    const int nig = WGM * nN, gid = wgid / nig, fm = gid * WGM, gsz = (nM - fm) < WGM ? (nM - fm) : WGM;
    pm = fm + ((wgid % nig) % gsz); pn = (wgid % nig) / gsz; return true;
}
template <class Prog>
__device__ __forceinline__ void gemm_phase(LAS unsigned char* lds, const int K, const Prog& S) {
    int tid_ = threadIdx.x; asm volatile("" : "+v"(tid_));
    const int tid = tid_, wid = __builtin_amdgcn_readfirstlane(tid >> 6), lane = tid & 63, wr = wid >> 2, wc = wid & 3, fr = lane & 15, fq = lane >> 4;
    const int nt = K / BK;
    unsigned voffA[2], voffB[2];
#pragma unroll
    for (int i = 0; i < 2; ++i) { int R, C; stage_rc(tid * 16 + i * 8192, R, C); const int Rb = Prog::PERM ? ((R & ~31) + perm32(R & 31)) : R;
        voffA[i] = (unsigned)(R * K + C) * 2u; voffB[i] = (unsigned)(Rb * K + C) * 2u; }
    const size_t kstep = (size_t)(BK * 2);
    const size_t hstep = (size_t)HALF * K * 2;
    const unsigned ldsw = (unsigned)wid * 1024u;
    const int aoff = lds_byte(wr * 64 + fr, fq * 8), boff = lds_byte(wc * 32 + fr, fq * 8);
#define PG8_SA(b, h) (((b) * 2 + (h)) * HTB)
#define PG8_SB(b, h) ((4 + (b) * 2 + (h)) * HTB)
#define PG8_STAGE(bufoff, gbase, voff) do { _Pragma("unroll") for (int _i = 0; _i < 2; ++_i) \
        __builtin_amdgcn_global_load_lds((const unsigned*)((const char*)(gbase) + (voff)[_i]), (LAS unsigned*)(lds + (bufoff) + ldsw + _i * 8192), 16, 0, 0); } while (0)
#define PG8_LDA(dst, b, h) do { _Pragma("unroll") for (int m = 0; m < 4; ++m) _Pragma("unroll") for (int k = 0; k < 2; ++k) dst[m][k] = *(const LAS bf16x8*)(lds + PG8_SA(b, h) + aoff + m * 2048 + k * 1024); } while (0)
#define PG8_LDB(dst, b, h) do { _Pragma("unroll") for (int n = 0; n < 2; ++n) _Pragma("unroll") for (int k = 0; k < 2; ++k) dst[n][k] = *(const LAS bf16x8*)(lds + PG8_SB(b, h) + boff + n * 2048 + k * 1024); } while (0)
#define PG8_MMA(ai, bj, At, Bt) do { __builtin_amdgcn_s_setprio(1); _Pragma("unroll") for (int m = 0; m < 4; ++m) _Pragma("unroll") for (int n = 0; n < 2; ++n) _Pragma("unroll") for (int k = 0; k < 2; ++k) \
        acc[ai][bj][m][n] = __builtin_amdgcn_mfma_f32_16x16x32_bf16(Bt[n][k], At[m][k], acc[ai][bj][m][n], 0, 0, 0); __builtin_amdgcn_s_setprio(0); } while (0)
#define PG8_WAIT_V(n) asm volatile("s_waitcnt vmcnt(" #n ")" ::: "memory")
#define PG8_WAIT_L(n) asm volatile("s_waitcnt lgkmcnt(" #n ")" ::: "memory")
#define PG8_BAR __builtin_amdgcn_s_barrier()
#define PG8_SCHED __builtin_amdgcn_sched_barrier(0)
    Unit cur, nxt; int ui = 0;
    if (!S.next(0, cur)) return;
    f32x4 acc[2][2][4][2];
#pragma unroll
    for (int a = 0; a < 2; ++a)
#pragma unroll
        for (int b = 0; b < 2; ++b)
#pragma unroll
            for (int m = 0; m < 4; ++m)
#pragma unroll
                for (int n = 0; n < 2; ++n) acc[a][b][m][n] = (f32x4){0.f, 0.f, 0.f, 0.f};
    bf16x8 At[4][2], B0[2][2], B1[2][2];
    const char* cA = cur.a; const char* cB = cur.b;
    PG8_STAGE(PG8_SB(0, 0), cB, voffB); PG8_STAGE(PG8_SA(0, 0), cA, voffA); PG8_STAGE(PG8_SB(0, 1), cB + hstep, voffB); PG8_STAGE(PG8_SA(0, 1), cA + hstep, voffA);
    if (wr == 1) PG8_BAR;
    PG8_WAIT_V(4); PG8_BAR;
    PG8_STAGE(PG8_SB(1, 0), cB + kstep, voffB); PG8_STAGE(PG8_SA(1, 0), cA + kstep, voffA); PG8_STAGE(PG8_SB(1, 1), cB + hstep + kstep, voffB);
    PG8_WAIT_V(6); PG8_BAR;
    for (;;) {
        const bool has_next = S.next(ui + 1, nxt);
        const char* nA = has_next ? nxt.a : cA; const char* nB = has_next ? nxt.b : cB;
        for (int t = 0; t < nt; t += 2) {
            const bool last = (t == nt - 2);
            const char* a1 = cA + (size_t)(t + 1) * kstep;
            const char* a2 = last ? nA : cA + (size_t)(t + 2) * kstep; const char* b2 = last ? nB : cB + (size_t)(t + 2) * kstep;
            const char* a3 = a2 + kstep; const char* b3 = b2 + kstep;
            PG8_LDB(B0, 0, 0); PG8_SCHED; PG8_LDA(At, 0, 0); PG8_STAGE(PG8_SA(1, 1), a1 + hstep, voffA);
            PG8_WAIT_L(8); PG8_BAR; PG8_WAIT_L(0); PG8_MMA(0, 0, At, B0); PG8_BAR; PG8_SCHED;
            PG8_LDB(B1, 0, 1); PG8_STAGE(PG8_SB(0, 0), b2, voffB);
            PG8_BAR; PG8_WAIT_L(0); PG8_MMA(0, 1, At, B1); PG8_BAR;
            PG8_LDA(At, 0, 1); PG8_STAGE(PG8_SA(0, 0), a2, voffA);
            PG8_BAR; PG8_WAIT_L(0); PG8_MMA(1, 0, At, B0); PG8_BAR; PG8_SCHED;
            PG8_STAGE(PG8_SB(0, 1), b2 + hstep, voffB);
            PG8_WAIT_V(6); PG8_BAR; PG8_MMA(1, 1, At, B1); PG8_BAR;
            PG8_LDB(B0, 1, 0); PG8_SCHED; PG8_LDA(At, 1, 0); PG8_STAGE(PG8_SA(0, 1), a2 + hstep, voffA);
            PG8_WAIT_L(8); PG8_BAR; PG8_WAIT_L(0); PG8_MMA(0, 0, At, B0); PG8_BAR; PG8_SCHED;
            PG8_LDB(B1, 1, 1); PG8_STAGE(PG8_SB(1, 0), b3, voffB);
            PG8_BAR; PG8_WAIT_L(0); PG8_MMA(0, 1, At, B1); PG8_BAR;
            PG8_LDA(At, 1, 1); PG8_STAGE(PG8_SA(1, 0), a3, voffA);
            PG8_BAR; PG8_WAIT_L(0); PG8_MMA(1, 0, At, B0); PG8_BAR; PG8_SCHED;
            PG8_STAGE(PG8_SB(1, 1), b3 + hstep, voffB);
            PG8_WAIT_V(6); PG8_BAR; PG8_MMA(1, 1, At, B1); PG8_BAR;
        }
        S.epi(acc, cur, wr, wc, fr, fq);
        if (!S.keep(cur)) {
#pragma unroll
            for (int a = 0; a < 2; ++a)
#pragma unroll
                for (int b = 0; b < 2; ++b)
#pragma unroll
                    for (int m = 0; m < 4; ++m)
#pragma unroll
                        for (int n = 0; n < 2; ++n) acc[a][b][m][n] = (f32x4){0.f, 0.f, 0.f, 0.f};
        }
        if (!has_next) break;
        cur = nxt; cA = nA; cB = nB; ++ui;
    }
    PG8_WAIT_V(0);
    if (wr == 0) PG8_BAR;
    PG8_BAR;
#undef PG8_SA
#undef PG8_SB
#undef PG8_STAGE
#undef PG8_LDA
#undef PG8_LDB
#undef PG8_MMA
#undef PG8_WAIT_V
#undef PG8_WAIT_L
#undef PG8_BAR
#undef PG8_SCHED
}
}

struct InProj {
    static constexpr bool PERM = true;
    const bf16_t* A; const bf16_t* Bt; bf16_t* Z; const float* rowss; const float* cosR; const float* sinR; int G, c;
    int pm0; const LAS float* rsl;
    __device__ __forceinline__ bool next(int i, pg8::Unit& u) const {
        if (!pg8::tile_order((long)i * G + c, T_TOK / 256, NIN / 256, u.pm, u.pn)) return false;
        u.a = (const char*)(A + (size_t)u.pm * 256 * DM); u.b = (const char*)(Bt + (size_t)u.pn * 256 * DM); u.sub = 0; return true;
    }
    __device__ __forceinline__ bool keep(const pg8::Unit&) const { return false; }
    __device__ __forceinline__ void epi(f32x4 (&acc)[2][2][4][2], const pg8::Unit& u, int wr, int wc, int fr, int fq) const {
        const int row0 = u.pm * 256 + wr * 64 + fr, col0 = u.pn * 256 + wc * 32 + 8 * fq;
        const int pn = u.pn;
        const int mode = (pn < 8) ? 1 : ((pn >= 12 && pn < 16) || (pn >= 20 && pn < 24) || (pn >= 30 && pn < 34)) ? 2 : (pn >= 34 ? 3 : 0);
        const float ksc = (pn >= 4 && pn < 8) ? 0.0625f : 1.0f;
        float rsv[2][4];
        if (u.pm == pm0) {
#pragma unroll
            for (int ai = 0; ai < 2; ++ai)
#pragma unroll
                for (int m = 0; m < 4; ++m) rsv[ai][m] = rsl[ai * 128 + wr * 64 + m * 16 + fr];
        } else {
            f32x4 pa[2][4], pb[2][4];
#pragma unroll
            for (int ai = 0; ai < 2; ++ai)
#pragma unroll
                for (int m = 0; m < 4; ++m) { const f32x4* rp = (const f32x4*)(rowss + (size_t)(row0 + ai * 128 + m * 16) * 32) + fq * 2; pa[ai][m] = rp[0]; pb[ai][m] = rp[1]; }
#pragma unroll
            for (int ai = 0; ai < 2; ++ai)
#pragma unroll
                for (int m = 0; m < 4; ++m) { const f32x4 t4 = pa[ai][m] + pb[ai][m]; float sm = (t4[0] + t4[1]) + (t4[2] + t4[3]); sm += __shfl_xor(sm, 16); sm += __shfl_xor(sm, 32);
                    rsv[ai][m] = rsqrtf(sm * (1.0f / DM) + 1e-6f); }
        }
        if (mode == 1) {
            f32x4 ci[2];
#pragma unroll
            for (int n = 0; n < 2; ++n)
#pragma unroll
                for (int j = 0; j < 4; ++j) ci[n][j] = exp2f(-(float)(wc * 32 + 8 * fq + 4 * n + j) * (13.287712379549449f / 127.0f)) * 0.15915494309189535f;
#pragma unroll
            for (int ai = 0; ai < 2; ++ai) {
#pragma unroll
                for (int m = 0; m < 4; ++m) {
                    const int row = row0 + ai * 128 + m * 16; const float rs = rsv[ai][m] * ksc; const float fp = (float)(row & (SEQ - 1));
                    bf16_t* rowp = Z + (size_t)row * NIN + col0;
                    f32x4 o0[2], o1[2];
#pragma unroll
                    for (int n = 0; n < 2; ++n) { f32x4 cs, sn;
#pragma unroll
                        for (int j = 0; j < 4; ++j) { float sa, ca; hw_sincos_rev(fp * ci[n][j], sa, ca); sn[j] = sa; cs[j] = ca; }
                        const f32x4 x1 = acc[ai][0][m][n] * rs, x2 = acc[ai][1][m][n] * rs; o0[n] = x1 * cs - x2 * sn; o1[n] = x2 * cs + x1 * sn; }
                    u32x4 w; w.x = cvt_pk_bf16(o0[0][0], o0[0][1]); w.y = cvt_pk_bf16(o0[0][2], o0[0][3]); w.z = cvt_pk_bf16(o0[1][0], o0[1][1]); w.w = cvt_pk_bf16(o0[1][2], o0[1][3]);
                    *(u32x4*)(rowp) = w;
                    w.x = cvt_pk_bf16(o1[0][0], o1[0][1]); w.y = cvt_pk_bf16(o1[0][2], o1[0][3]); w.z = cvt_pk_bf16(o1[1][0], o1[1][1]); w.w = cvt_pk_bf16(o1[1][2], o1[1][3]);
                    *(u32x4*)(rowp + 128) = w;
                }
            }
            return;
        }
#pragma unroll
        for (int ai = 0; ai < 2; ++ai)
#pragma unroll
            for (int m = 0; m < 4; ++m) {
                const int row = row0 + ai * 128 + m * 16;
                const float rs = rsv[ai][m];
                f32x4 v[2][2];
#pragma unroll
                for (int bj = 0; bj < 2; ++bj)
#pragma unroll
                    for (int n = 0; n < 2; ++n) v[bj][n] = acc[ai][bj][m][n] * rs;
                if (mode == 2) {
#pragma unroll
                    for (int bj = 0; bj < 2; ++bj)
#pragma unroll
                        for (int n = 0; n < 2; ++n)
#pragma unroll
                            for (int j = 0; j < 4; ++j) v[bj][n][j] = silu_f(v[bj][n][j]);
                } else if (mode == 3) {
#pragma unroll
                    for (int bj = 0; bj < 2; ++bj)
#pragma unroll
                        for (int n = 0; n < 2; ++n)
#pragma unroll
                            for (int j = 0; j < 4; ++j) v[bj][n][j] = sigm_f(v[bj][n][j]);
                }
                bf16_t* rowp = Z + (size_t)row * NIN + col0;
#pragma unroll
                for (int bj = 0; bj < 2; ++bj) {
                    u32x4 w; w.x = cvt_pk_bf16(v[bj][0][0], v[bj][0][1]); w.y = cvt_pk_bf16(v[bj][0][2], v[bj][0][3]); w.z = cvt_pk_bf16(v[bj][1][0], v[bj][1][1]); w.w = cvt_pk_bf16(v[bj][1][2], v[bj][1][3]);
                    *(u32x4*)(rowp + bj * 128) = w;
                }
            }
    }
};

struct MergeP {
    static constexpr bool PERM = true;
    const bf16_t *Y0, *W0; const bf16_t* Z; bf16_t* Mg; int G, c;
    __device__ __forceinline__ bool next(int i, pg8::Unit& u) const {
        const int ti = i / 3; u.sub = i - ti * 3;
        if (!pg8::tile_order((long)ti * G + c, T_TOK / 256, DM / 256, u.pm, u.pn)) return false;
        const bf16_t* yy = Y0 + (size_t)u.sub * (SZ_Y / 2); const bf16_t* ww = W0 + (size_t)u.sub * (DEPTH * SZ_WBR / 2);
        u.a = (const char*)(yy + (size_t)u.pm * 256 * 1024); u.b = (const char*)(ww + (size_t)u.pn * 256 * 1024); return true;
    }
    __device__ __forceinline__ bool keep(const pg8::Unit& u) const { return u.sub < 2; }
    __device__ __forceinline__ void epi(f32x4 (&acc)[2][2][4][2], const pg8::Unit& u, int wr, int wc, int fr, int fq) const {
        const int row0 = u.pm * 256 + wr * 64 + fr, col0 = u.pn * 256 + wc * 32 + 8 * fq;
        const int sub = u.sub;
        u32x4 gn[4][2][2], gd[4][2][2];
        const int dsub = sub < 2 ? sub + 1 : sub;
#define MG_LOAD(q) do { _Pragma("unroll") for (int mm = 0; mm < 2; ++mm) _Pragma("unroll") for (int bj = 0; bj < 2; ++bj) { \
            const bf16_t* gp = Z + (size_t)(row0 + ((q) >> 1) * 128 + (((q) & 1) * 2 + mm) * 16) * NIN + C_MG + col0 + bj * 128; \
            gn[q][mm][bj] = *(const u32x4*)(gp + sub * DM); if (sub < 2) gd[q][mm][bj] = *(const u32x4*)(gp + dsub * DM); else gd[q][mm][bj] = (u32x4){0u, 0u, 0u, 0u}; } } while (0)
#define MG_APPLY(q) do { _Pragma("unroll") for (int mm = 0; mm < 2; ++mm) _Pragma("unroll") for (int bj = 0; bj < 2; ++bj) { \
            const int ai = (q) >> 1, m = ((q) & 1) * 2 + mm; const u32x4 a4 = gn[q][mm][bj], d4 = gd[q][mm][bj]; \
            f32x4 f0 = (f32x4){lo16(a4[0]), hi16(a4[0]), lo16(a4[1]), hi16(a4[1])}, f1 = (f32x4){lo16(a4[2]), hi16(a4[2]), lo16(a4[3]), hi16(a4[3])}; \
            if (sub < 2) { \
                f0[0] *= __builtin_amdgcn_rcpf(lo16(d4[0])); f0[1] *= __builtin_amdgcn_rcpf(hi16(d4[0])); f0[2] *= __builtin_amdgcn_rcpf(lo16(d4[1])); f0[3] *= __builtin_amdgcn_rcpf(hi16(d4[1])); \
                f1[0] *= __builtin_amdgcn_rcpf(lo16(d4[2])); f1[1] *= __builtin_amdgcn_rcpf(hi16(d4[2])); f1[2] *= __builtin_amdgcn_rcpf(lo16(d4[3])); f1[3] *= __builtin_amdgcn_rcpf(hi16(d4[3])); } \
            acc[ai][bj][m][0] *= f0; acc[ai][bj][m][1] *= f1; \
            if (sub == 2) { const f32x4 v0 = acc[ai][bj][m][0], v1 = acc[ai][bj][m][1]; \
                u32x4 w; w.x = cvt_pk_bf16(v0[0], v0[1]); w.y = cvt_pk_bf16(v0[2], v0[3]); w.z = cvt_pk_bf16(v1[0], v1[1]); w.w = cvt_pk_bf16(v1[2], v1[3]); \
                *(u32x4*)(Mg + (size_t)(row0 + ai * 128 + m * 16) * DM + col0 + bj * 128) = w; } } } while (0)
        MG_LOAD(0); MG_LOAD(1);
        MG_APPLY(0); MG_LOAD(2);
        MG_APPLY(1); MG_LOAD(3);
        MG_APPLY(2); MG_APPLY(3);
#undef MG_LOAD
#undef MG_APPLY
    }
};

struct OutProj {
    static constexpr bool PERM = false;
    const bf16_t* A; const bf16_t* Bt; const float* xin; float* xout; bf16_t* xb; float* rowss_next; int G, c;
    __device__ __forceinline__ bool next(int i, pg8::Unit& u) const {
        if (!pg8::tile_order((long)i * G + c, T_TOK / 256, DM / 256, u.pm, u.pn)) return false;
        u.a = (const char*)(A + (size_t)u.pm * 256 * DM); u.b = (const char*)(Bt + (size_t)u.pn * 256 * DM); u.sub = 0; return true;
    }
    __device__ __forceinline__ bool keep(const pg8::Unit&) const { return false; }
    __device__ __forceinline__ void epi(f32x4 (&acc)[2][2][4][2], const pg8::Unit& u, int wr, int wc, int fr, int fq) const {
        const int row0 = u.pm * 256 + wr * 64 + fr, col0 = u.pn * 256 + wc * 32 + 4 * fq;
#pragma unroll
        for (int ai = 0; ai < 2; ++ai) {
            f32x4 xo[4][2][2];
#pragma unroll
            for (int m = 0; m < 4; ++m)
#pragma unroll
                for (int bj = 0; bj < 2; ++bj)
#pragma unroll
                    for (int n = 0; n < 2; ++n) xo[m][bj][n] = *(const f32x4*)(xin + (size_t)(row0 + ai * 128 + m * 16) * DM + col0 + bj * 128 + n * 16);
#pragma unroll
            for (int m = 0; m < 4; ++m) {
                const int row = row0 + ai * 128 + m * 16;
                const size_t off = (size_t)row * DM + col0;
                float ss = 0.f;
#pragma unroll
                for (int bj = 0; bj < 2; ++bj)
#pragma unroll
                    for (int n = 0; n < 2; ++n) {
                        const f32x4 o = xo[m][bj][n] + acc[ai][bj][m][n];
                        *(f32x4*)(xout + off + bj * 128 + n * 16) = o;
                        ss += o[0] * o[0] + o[1] * o[1] + o[2] * o[2] + o[3] * o[3];
                        if (rowss_next) { u32x2 w; w.x = cvt_pk_bf16(o[0], o[1]); w.y = cvt_pk_bf16(o[2], o[3]); *(u32x2*)(xb + off + bj * 128 + n * 16) = w; }
                    }
                if (rowss_next) {
                    ss += __shfl_xor(ss, 16); ss += __shfl_xor(ss, 32);
                    if (fq == 0) rowss_next[(size_t)row * 32 + u.pn * 4 + wc] = ss;
                }
            }
        }
    }
};

__device__ void tconv(const float* __restrict__ src, bf16_t* __restrict__ dst, int R, int C, const float* __restrict__ scale, float* tile) {
    const int tid = otid();
    const int ntc = C / 256, nt = (R / 64) * ntc;
    for (int t = blockIdx.x; t < nt; t += gridDim.x) {
        const int tr = t / ntc, tc = t - tr * ntc;
        {
            const int c4 = (tid & 63) * 4, r0 = tid >> 6;
            float4 v[8];
#pragma unroll
            for (int i = 0; i < 8; ++i) v[i] = *(const float4*)(src + (size_t)(tr * 64 + r0 + 8 * i) * C + tc * 256 + c4);
#pragma unroll
            for (int i = 0; i < 8; ++i) { const float sc = scale ? scale[tr * 64 + r0 + 8 * i] : 1.f; float* tp = tile + (r0 + 8 * i) * 257 + c4;
                tp[0] = v[i].x * sc; tp[1] = v[i].y * sc; tp[2] = v[i].z * sc; tp[3] = v[i].w * sc; }
        }
        __syncthreads();
#pragma unroll
        for (int i = 0; i < 4; ++i) {
            const int c = tid + 512 * i, kc = c & 7, n = c >> 3;
            const float* tp = tile + (kc * 8) * 257 + n;
            u32x4 o; o.x = cvt_pk_bf16(tp[0], tp[257]); o.y = cvt_pk_bf16(tp[514], tp[771]); o.z = cvt_pk_bf16(tp[1028], tp[1285]); o.w = cvt_pk_bf16(tp[1542], tp[1799]);
            *(u32x4*)(dst + (size_t)(tc * 256 + n) * R + tr * 64 + kc * 8) = o;
        }
        __syncthreads();
    }
}

__device__ void prologue(const Args& a, float* lds) {
    unsigned char* ws = a.ws;
    const int tid = otid(), lane = tid & 63, wave = tid >> 6;
    const size_t gtid = (size_t)blockIdx.x * NTHR + tid, gstr = (size_t)gridDim.x * NTHR;
    {
        const float* x = a.in[0]; bf16_t* xb = (bf16_t*)(ws + WS_XB); float* rowss = (float*)(ws + WS_ROWSS);
        for (int row = blockIdx.x * 8 + wave; row < T_TOK; row += gridDim.x * 8) {
            const float4* xp = (const float4*)(x + (size_t)row * DM); float ss = 0.f;
#pragma unroll
            for (int i = 0; i < 8; ++i) { const float4 v = xp[lane + 64 * i]; ss += v.x * v.x + v.y * v.y + v.z * v.z + v.w * v.w;
                u32x2 o; o.x = cvt_pk_bf16(v.x, v.y); o.y = cvt_pk_bf16(v.z, v.w); *(u32x2*)(xb + (size_t)row * DM + (lane + 64 * i) * 4) = o; }
            ss = wave_sum(ss);
            if (lane < 32) rowss[(size_t)row * 32 + lane] = lane == 0 ? ss : 0.f;
        }
    }
    if (blockIdx.x == 0) { if (tid < 64) ((unsigned*)(ws + WS_CTR))[tid] = 0u; for (int i = tid; i < 4096; i += NTHR) ((unsigned*)(ws + WS_BAR))[i] = 0u; }
    {
        float* cR = (float*)(ws + WS_COSR); float* sR = (float*)(ws + WS_SINR); float* cA = (float*)(ws + WS_COSA); float* sA = (float*)(ws + WS_SINA);
        for (size_t i = gtid; i < (size_t)SEQ * 128; i += gstr) { const int s = (int)(i >> 7), k = (int)(i & 127);
            const float inv = 1.0f / exp2f((float)k * (1.0f / 127.0f) * 13.287712379549449f); float sn, cs; sincos_red((float)s * inv, sn, cs); cR[i] = cs; sR[i] = sn; }
        for (size_t i = gtid; i < (size_t)SEQ * 16; i += gstr) { const int s = (int)(i >> 4), k = (int)(i & 15);
            const float inv = exp2f(-(float)k * (1.0f / 16.0f) * 18.931568569324174f); float sn, cs; sincos_red((float)s * inv, sn, cs); cA[i] = cs; sA[i] = sn; }
    }
    for (int l = 0; l < DEPTH; ++l) {
        tconv(a.in[2] + (size_t)l * DM * NIN, (bf16_t*)(ws + WS_WIN + l * SZ_WIN), DM, NIN, a.in[1] + l * DM, lds);
        tconv(a.in[10] + (size_t)l * 1024 * DM, (bf16_t*)(ws + WS_WRET + l * SZ_WBR), 1024, DM, nullptr, lds);
        tconv(a.in[11] + (size_t)l * 1024 * DM, (bf16_t*)(ws + WS_WPOOL + l * SZ_WBR), 1024, DM, nullptr, lds);
        tconv(a.in[12] + (size_t)l * 1024 * DM, (bf16_t*)(ws + WS_WATT + l * SZ_WBR), 1024, DM, nullptr, lds);
        tconv(a.in[13] + (size_t)l * DM * DM, (bf16_t*)(ws + WS_WOUT + l * SZ_WOUT), DM, DM, nullptr, lds);
        for (int g = 0; g < 4; ++g) tconv(a.in[5] + ((size_t)l * 4 + g) * 65536, (bf16_t*)(ws + WS_PW + l * SZ_PW) + g * 65536, 256, 256, nullptr, lds);
    }
}

__device__ void ret_scan_naive(const Args& a, int l) {
    const bf16_t* Z = (const bf16_t*)(a.ws + WS_Z);
    const size_t gtid = (size_t)blockIdx.x * NTHR + otid(), gstr = (size_t)gridDim.x * NTHR;
    for (size_t idx = gtid; idx < (size_t)2097152; idx += gstr) {
        const int d = (int)(idx & 255), e = (int)((idx >> 8) & 255), dir = (int)((idx >> 16) & 1), bh = (int)(idx >> 17), b = bh >> 2, h = bh & 3;
        const float lg = -expf(a.in[dir ? 4 : 3][l * 4 + h]);
        const float dec = expf(lg * 128.f);
        bf16_t* ST = (bf16_t*)(a.ws + (dir ? WS_SB : WS_SF));
        float st = 0.f;
        for (int step = 0; step < 32; ++step) {
            const int n = dir ? 31 - step : step;
            ST[(((size_t)bh * 32 + n) * 256 + e) * 256 + d] = f2bf(st);
            float kv = 0.f;
            const bf16_t* zp = Z + (size_t)(b * SEQ + n * 128) * NIN + h * 256;
            for (int j = 0; j < 128; ++j) {
                const float w = dir ? expf(lg * (float)j) : expf(lg * (float)(127 - j));
                kv += bf2f(zp[(size_t)j * NIN + C_RK + d]) * w * bf2f(zp[(size_t)j * NIN + C_RV + e]);
            }
            st = st * dec + kv;
        }
    }
}

__device__ void ret_out_naive(const Args& a, int l, float* P) {
    const bf16_t* Z = (const bf16_t*)(a.ws + WS_Z); bf16_t* Ya = (bf16_t*)(a.ws + WS_YA);
    const bf16_t* SF = (const bf16_t*)(a.ws + WS_SF); const bf16_t* SB = (const bf16_t*)(a.ws + WS_SB);
    const int tid = otid();
    for (int item = blockIdx.x; item < 512; item += gridDim.x) {
        const int b = item >> 7, n = (item >> 2) & 31, h = item & 3, bh = b * 4 + h;
        const int t0 = b * SEQ + n * 128;
        const float lgf = -expf(a.in[3][l * 4 + h]), lgb = -expf(a.in[4][l * 4 + h]);
        for (int p = tid; p < 16384; p += NTHR) {
            const int j = p >> 7, k = p & 127;
            const bf16_t* qp = Z + (size_t)(t0 + j) * NIN + C_RQ + h * 256; const bf16_t* kp = Z + (size_t)(t0 + k) * NIN + C_RK + h * 256;
            float dot = 0.f;
            for (int d = 0; d < 256; ++d) dot += bf2f(qp[d]) * bf2f(kp[d]);
            const int lag = j - k;
            P[p] = dot * (lag >= 0 ? expf(lgf * (float)lag) : expf(lgb * (float)(-lag)));
        }
        __syncthreads();
        for (int pass = 0; pass < 4; ++pass) {
            const int j = pass * 32 + (tid >> 4), eg = tid & 15;
            float o[16];
#pragma unroll
            for (int i = 0; i < 16; ++i) o[i] = 0.f;
            for (int k = 0; k < 128; ++k) {
                const float pv = P[j * 128 + k];
                const bf16_t* vp = Z + (size_t)(t0 + k) * NIN + C_RV + h * 256 + eg * 16;
#pragma unroll
                for (int i = 0; i < 16; ++i) o[i] += pv * bf2f(vp[i]);
            }
            const bf16_t* qp = Z + (size_t)(t0 + j) * NIN + C_RQ + h * 256;
            const float qf = expf(lgf * (float)(j + 1)), qb = expf(lgb * (float)(128 - j));
#pragma unroll
            for (int i = 0; i < 16; ++i) {
                const size_t so = (((size_t)bh * 32 + n) * 256 + eg * 16 + i) * 256;
                float cf = 0.f, cb = 0.f;
                for (int d = 0; d < 256; ++d) { const float qv = bf2f(qp[d]); cf += qv * bf2f(SF[so + d]); cb += qv * bf2f(SB[so + d]); }
                o[i] += qf * cf + qb * cb;
            }
            float ss = 0.f;
#pragma unroll
            for (int i = 0; i < 16; ++i) ss += o[i] * o[i];
            ss += __shfl_xor(ss, 1); ss += __shfl_xor(ss, 2); ss += __shfl_xor(ss, 4); ss += __shfl_xor(ss, 8);
            const float rs = rsqrtf(ss * (1.0f / 256.0f) + 1e-6f);
            const bf16_t* gp = Z + (size_t)(t0 + j) * NIN + C_RG + h * 256 + eg * 16;
            bf16_t* yp = Ya + (size_t)(t0 + j) * 1024 + h * 256 + eg * 16;
#pragma unroll
            for (int i = 0; i < 16; ++i) yp[i] = f2bf(o[i] * rs * bf2f(gp[i]));
        }
        __syncthreads();
    }
}

__device__ void attn_naive(const Args& a, int l, float* lds) {
    const bf16_t* Z = (const bf16_t*)(a.ws + WS_Z); bf16_t* Yc = (bf16_t*)(a.ws + WS_YC);
    const float* cA = (const float*)(a.ws + WS_COSA); const float* sA = (const float*)(a.ws + WS_SINA);
    const float* qg = a.in[7] + l * 128; const float* kg = a.in[8] + l * 128; const float* sink = a.in[9] + l * 8;
    float* qs = lds; float* ps = lds + 8 * 128;
    const int tid = otid(), lane = tid & 63, wave = tid >> 6;
    for (int w0 = blockIdx.x * 8; w0 < T_TOK * 8; w0 += gridDim.x * 8) {
        const int qi = w0 + wave, t = qi >> 3, hq = qi & 7, kvh = hq >> 2, pos = t & (SEQ - 1), b = t >> 12;
        const bf16_t* qp = Z + (size_t)t * NIN + C_AQ + hq * 128;
        {
            const float x0 = bf2f(qp[lane]), x1 = bf2f(qp[lane + 64]);
            const float ss = wave_sum(x0 * x0 + x1 * x1); const float rs = rsqrtf(ss * (1.0f / 128.0f) + 1e-6f);
            qs[wave * 128 + lane] = x0 * rs * qg[lane]; qs[wave * 128 + lane + 64] = x1 * rs * qg[lane + 64];
        }
        __syncthreads();
        float rot = 0.f;
        if (lane < 32) { const int i = lane & 15; const float xa = qs[wave * 128 + i], xb = qs[wave * 128 + i + 16], c = cA[pos * 16 + i], s = sA[pos * 16 + i]; rot = lane < 16 ? xa * c - xb * s : xb * c + xa * s; }
        __syncthreads();
        if (lane < 32) qs[wave * 128 + lane] = rot;
        __syncthreads();
        float sc[5]; const float skv = sink[hq]; float mx = skv;
#pragma unroll
        for (int r = 0; r < 5; ++r) {
            const int jrel = lane + 64 * r, kp = pos - 128 + jrel; const bool valid = (jrel <= 256) && (kp >= 0) && (kp < SEQ);
            float s = -1e30f;
            if (valid) {
                const bf16_t* kr = Z + (size_t)(b * SEQ + kp) * NIN + C_AK + kvh * 128;
                float kss = 0.f;
                for (int d = 0; d < 128; ++d) { const float kv = bf2f(kr[d]); kss += kv * kv; }
                const float rsk = rsqrtf(kss * (1.0f / 128.0f) + 1e-6f);
                float dot = 0.f;
                for (int i = 0; i < 16; ++i) { const float xa = bf2f(kr[i]) * kg[i], xb = bf2f(kr[i + 16]) * kg[i + 16], c = cA[kp * 16 + i], sn = sA[kp * 16 + i];
                    dot += (xa * c - xb * sn) * qs[wave * 128 + i] + (xb * c + xa * sn) * qs[wave * 128 + i + 16]; }
                for (int d = 32; d < 128; ++d) dot += bf2f(kr[d]) * kg[d] * qs[wave * 128 + d];
                s = dot * rsk * 0.08838834764831845f;
            }
            sc[r] = s; mx = fmaxf(mx, s);
        }
        mx = wave_max(mx);
        float sum = 0.f;
#pragma unroll
        for (int r = 0; r < 5; ++r) { const float p = __expf(sc[r] - mx); sc[r] = p; sum += p; }
        sum = wave_sum(sum) + __expf(skv - mx);
        const float isum = 1.0f / sum;
#pragma unroll
        for (int r = 0; r < 5; ++r) ps[wave * 320 + lane + 64 * r] = sc[r] * isum;
        __syncthreads();
        float o0 = 0.f, o1 = 0.f;
        for (int jrel = 0; jrel <= 256; ++jrel) { const int kp = pos - 128 + jrel; if (kp < 0 || kp >= SEQ) continue;
            const float p = ps[wave * 320 + jrel]; const bf16_t* vr = Z + (size_t)(b * SEQ + kp) * NIN + C_AV + kvh * 128; o0 += p * bf2f(vr[lane]); o1 += p * bf2f(vr[lane + 64]); }
        const bf16_t* gp = Z + (size_t)t * NIN + C_AG + hq * 128; bf16_t* yp = Yc + (size_t)t * 1024 + hq * 128;
        yp[lane] = f2bf(o0 * bf2f(gp[lane])); yp[lane + 64] = f2bf(o1 * bf2f(gp[lane + 64]));
        __syncthreads();
    }
}

__device__ void pool_naive(const Args& a, int l, float* P) {
    const bf16_t* Z = (const bf16_t*)(a.ws + WS_Z); bf16_t* Yb = (bf16_t*)(a.ws + WS_YB);
    const float* pw = a.in[5] + (size_t)l * 4 * 65536; const float* psc = a.in[6] + l * 1024;
    const int tid = otid();
    for (int tile = blockIdx.x; tile < T_TOK / 16; tile += gridDim.x) {
        const int t0 = tile * 16;
        for (int p = tid; p < 16 * 1024; p += NTHR) {
            const int tt = p >> 10, c = p & 1023, g = c >> 8, hw = 1 << g;
            const int t = t0 + tt, pos = t & (SEQ - 1), bb = t - pos;
            int lo = pos - hw, hi = pos + hw; lo = lo < 0 ? 0 : lo; hi = hi > SEQ ? SEQ : hi;
            float s = 0.f;
            for (int q = lo; q < hi; ++q) s += bf2f(Z[(size_t)(bb + q) * NIN + C_PV + c]);
            P[p] = s / (float)(hi - lo) - bf2f(Z[(size_t)t * NIN + C_PV + c]);
        }
        __syncthreads();
        for (int p = tid; p < 16 * 1024; p += NTHR) {
            const int tt = p >> 10, c = p & 1023, g = c >> 8, e = c & 255;
            const float* pp = P + tt * 1024 + g * 256; const float* wp = pw + (size_t)g * 65536 + e;
            float acc = 0.f;
            for (int d = 0; d < 256; ++d) acc += pp[d] * wp[(size_t)d * 256];
            const int t = t0 + tt;
            Yb[(size_t)t * 1024 + c] = f2bf(acc * psc[c] * bf2f(Z[(size_t)t * NIN + C_PG + c]));
        }
        __syncthreads();
    }
}


typedef short bf16x4 __attribute__((ext_vector_type(4)));
__device__ __forceinline__ f32x4 mfma16(bf16x8 a, bf16x8 b, f32x4 c) { return __builtin_amdgcn_mfma_f32_16x16x32_bf16(a, b, c, 0, 0, 0); }
__device__ __forceinline__ bf16x4 trr(LAS unsigned char* p) { return __builtin_amdgcn_ds_read_tr16_b64_v4i16((LAS bf16x4*)p); }
__device__ __forceinline__ bf16x8 cat8(bf16x4 a, bf16x4 b) { return __builtin_shufflevector(a, b, 0, 1, 2, 3, 4, 5, 6, 7); }
__device__ __forceinline__ bf16x8 pack8(f32x4 a, f32x4 b) { u32x4 w; w.x = cvt_pk_bf16(a[0], a[1]); w.y = cvt_pk_bf16(a[2], a[3]); w.z = cvt_pk_bf16(b[0], b[1]); w.w = cvt_pk_bf16(b[2], b[3]); return __builtin_bit_cast(bf16x8, w); }

__device__ __forceinline__ void pool_item(const Args& a, int l, int it, LAS unsigned char* lds, int tid) {
    const bf16_t* Z = (const bf16_t*)(a.ws + WS_Z); bf16_t* Yb = (bf16_t*)(a.ws + WS_YB);
    const bf16_t* PWt = (const bf16_t*)(a.ws + WS_PW + (size_t)l * SZ_PW); const float* psc = a.in[6] + l * 1024;
    const int lane = tid & 63, wave = tid >> 6, g = it & 3, tile = it >> 2, t0 = tile * 128, hw = 1 << g;
    LAS unsigned char* Us = lds; LAS unsigned char* Ps = lds + 144 * 528;
    {
        const int pos0 = t0 & (SEQ - 1);
#pragma unroll
        for (int i = 0; i < 9; ++i) { const int c = tid + 512 * i, row = c >> 5, ch = c & 31, pos = pos0 - 8 + row;
            int tr = t0 - 8 + row; tr = tr < 0 ? 0 : (tr >= T_TOK ? T_TOK - 1 : tr);
            u32x4 v = *(const u32x4*)(Z + (size_t)tr * NIN + C_PV + g * 256 + ch * 8);
            const unsigned keep = (pos >= 0 && pos < SEQ) ? 0xffffffffu : 0u; v.x &= keep; v.y &= keep; v.z &= keep; v.w &= keep;
            *(LAS u32x4*)(Us + row * 528 + ch * 16) = v; }
    }
    __syncthreads();
    {
        const int c8 = (tid & 31) * 8, rg = tid >> 5, r0 = rg * 8, pos0 = (t0 & (SEQ - 1)) + r0;
        LAS unsigned char* ub = Us + (r0 + 8) * 528 + c8 * 2;
        f32x4 sa = (f32x4){0.f, 0.f, 0.f, 0.f}, sb = (f32x4){0.f, 0.f, 0.f, 0.f};
        for (int j = -hw; j < hw; ++j) { const u32x4 v = *(const LAS u32x4*)(ub + j * 528);
            sa += (f32x4){lo16(v.x), hi16(v.x), lo16(v.y), hi16(v.y)}; sb += (f32x4){lo16(v.z), hi16(v.z), lo16(v.w), hi16(v.w)}; }
#pragma unroll 1
        for (int i = 0; i < 8; ++i) {
            const int pos = pos0 + i; int lo = pos - hw, hi = pos + hw; lo = lo < 0 ? 0 : lo; hi = hi > SEQ ? SEQ : hi;
            const float ic = 1.0f / (float)(hi - lo);
            const u32x4 cv = *(const LAS u32x4*)(ub + i * 528), vin = *(const LAS u32x4*)(ub + (i + hw) * 528), vout = *(const LAS u32x4*)(ub + (i - hw) * 528);
            const f32x4 ca = (f32x4){lo16(cv.x), hi16(cv.x), lo16(cv.y), hi16(cv.y)}, cb = (f32x4){lo16(cv.z), hi16(cv.z), lo16(cv.w), hi16(cv.w)};
            *(LAS bf16x8*)(Ps + (r0 + i) * 528 + c8 * 2) = pack8(sa * ic - ca, sb * ic - cb);
            sa += (f32x4){lo16(vin.x), hi16(vin.x), lo16(vin.y), hi16(vin.y)} - (f32x4){lo16(vout.x), hi16(vout.x), lo16(vout.y), hi16(vout.y)};
            sb += (f32x4){lo16(vin.z), hi16(vin.z), lo16(vin.w), hi16(vin.w)} - (f32x4){lo16(vout.z), hi16(vout.z), lo16(vout.w), hi16(vout.w)};
        }
    }
    __syncthreads();
    const int wr = wave >> 2, wc = wave & 3, fr = lane & 15, fq = lane >> 4;
    f32x4 acc[4][4];
#pragma unroll
    for (int i = 0; i < 4; ++i)
#pragma unroll
        for (int j = 0; j < 4; ++j) acc[i][j] = (f32x4){0.f, 0.f, 0.f, 0.f};
    const bf16_t* Bp = PWt + (size_t)g * 65536 + (size_t)(wc * 64 + fr) * 256 + 8 * fq;
#pragma unroll 1
    for (int kh = 0; kh < 2; ++kh) {
        bf16x8 bfr[4][4];
#pragma unroll
        for (int k4 = 0; k4 < 4; ++k4)
#pragma unroll
            for (int nt = 0; nt < 4; ++nt) bfr[k4][nt] = *(const bf16x8*)(Bp + nt * 16 * 256 + (kh * 4 + k4) * 32);
#pragma unroll
        for (int k4 = 0; k4 < 4; ++k4) {
            bf16x8 af[4];
#pragma unroll
            for (int mt = 0; mt < 4; ++mt) af[mt] = *(const LAS bf16x8*)(Ps + (wr * 64 + mt * 16 + fr) * 528 + ((kh * 4 + k4) * 32 + 8 * fq) * 2);
#pragma unroll
            for (int mt = 0; mt < 4; ++mt)
#pragma unroll
                for (int nt = 0; nt < 4; ++nt) acc[mt][nt] = mfma16(bfr[k4][nt], af[mt], acc[mt][nt]);
        }
    }
    {
        u32x2 gt[4][4]; f32x4 scv[4];
#pragma unroll
        for (int nt = 0; nt < 4; ++nt) scv[nt] = *(const f32x4*)(psc + g * 256 + wc * 64 + nt * 16 + 4 * fq);
#pragma unroll
        for (int mt = 0; mt < 4; ++mt)
#pragma unroll
            for (int nt = 0; nt < 4; ++nt) gt[mt][nt] = *(const u32x2*)(Z + (size_t)(t0 + wr * 64 + mt * 16 + fr) * NIN + C_PG + g * 256 + wc * 64 + nt * 16 + 4 * fq);
#pragma unroll
        for (int mt = 0; mt < 4; ++mt) {
            const int t = t0 + wr * 64 + mt * 16 + fr;
#pragma unroll
            for (int nt = 0; nt < 4; ++nt) {
                const int c = g * 256 + wc * 64 + nt * 16 + 4 * fq;
                const f32x4 v = acc[mt][nt] * scv[nt]; const u32x2 gg = gt[mt][nt];
                u32x2 o; o.x = cvt_pk_bf16(v[0] * lo16(gg.x), v[1] * hi16(gg.x)); o.y = cvt_pk_bf16(v[2] * lo16(gg.y), v[3] * hi16(gg.y));
                *(u32x2*)(Yb + (size_t)t * 1024 + c) = o;
            }
        }
    }
}

#define ATT_CI(i) ((i) == 0 ? 1.591549431e-01f : (i) == 1 ? 7.008652159e-02f : (i) == 2 ? 3.086376340e-02f : (i) == 3 ? 1.359137064e-02f : (i) == 4 ? 5.985185713e-03f : (i) == 5 ? 2.635675899e-03f : \
    (i) == 6 ? 1.160663641e-03f : (i) == 7 ? 5.111175045e-04f : (i) == 8 ? 2.250790790e-04f : (i) == 9 ? 9.911730937e-05f : (i) == 10 ? 4.364795279e-05f : (i) == 11 ? 1.922110068e-05f : \
    (i) == 12 ? 8.464330808e-06f : (i) == 13 ? 3.727408602e-06f : (i) == 14 ? 1.641426263e-06f : 7.228293069e-07f)

__device__ __forceinline__ void attn_item(const Args& a, int l, int it, LAS unsigned char* lds, int tid) {
    const bf16_t* Z = (const bf16_t*)(a.ws + WS_Z); bf16_t* Yc = (bf16_t*)(a.ws + WS_YC);
    const float* cA = (const float*)(a.ws + WS_COSA); const float* sA = (const float*)(a.ws + WS_SINA);
    const float* qg = a.in[7] + l * 128; const float* kg = a.in[8] + l * 128; const float* sink = a.in[9] + l * 8;
    const int lane = tid & 63, wave = tid >> 6, fr = lane & 15, fq = lane >> 4;
    const int half = it & 1, kvh = (it >> 1) & 1, n = (it >> 2) & 31, b = it >> 7;
    const int hq = kvh * 4 + half * 2 + (wave >> 2), qrow0 = (wave & 3) * 32, tq0 = b * SEQ + n * 128;
    LAS unsigned char* Ks = lds; LAS unsigned char* Vs = lds + 128 * 272;
    LAS unsigned char* Qs = lds + 71680 + (wave * 32 + fr) * 272 + 16 * fq;
#pragma unroll
    for (int qt = 0; qt < 2; ++qt) {
        const int qrow = qrow0 + qt * 16 + fr, pos = n * 128 + qrow;
        const bf16_t* qp = Z + (size_t)(tq0 + qrow) * NIN + C_AQ + hq * 128 + 8 * fq;
        f32x4 x[4][2]; float ss = 0.f;
#pragma unroll
        for (int ks = 0; ks < 4; ++ks) { const u32x4 r = *(const u32x4*)(qp + ks * 32);
            x[ks][0] = (f32x4){lo16(r.x), hi16(r.x), lo16(r.y), hi16(r.y)}; x[ks][1] = (f32x4){lo16(r.z), hi16(r.z), lo16(r.w), hi16(r.w)};
            const f32x4 q0 = x[ks][0] * x[ks][0], q1 = x[ks][1] * x[ks][1]; ss += (q0[0] + q0[1]) + (q0[2] + q0[3]) + (q1[0] + q1[1]) + (q1[2] + q1[3]); }
        ss += __shfl_xor(ss, 16); ss += __shfl_xor(ss, 32);
        const float rs = rsqrtf(ss * (1.0f / 128.0f) + 1e-6f) * 0.08838834764831845f;
#pragma unroll
        for (int ks = 0; ks < 4; ++ks) { x[ks][0] *= *(const f32x4*)(qg + ks * 32 + 8 * fq) * rs; x[ks][1] *= *(const f32x4*)(qg + ks * 32 + 8 * fq + 4) * rs; }
        {
            f32x4 c0, c1, s0, s1; const float fp = (float)pos; const bool hi8 = (fq & 1) != 0;
#pragma unroll
            for (int j = 0; j < 4; ++j) { float sa, ca, sb, cb; hw_sincos_rev(fp * (hi8 ? ATT_CI(8 + j) : ATT_CI(j)), sa, ca); hw_sincos_rev(fp * (hi8 ? ATT_CI(12 + j) : ATT_CI(4 + j)), sb, cb); s0[j] = sa; c0[j] = ca; s1[j] = sb; c1[j] = cb; }
            f32x4 p0, p1;
#pragma unroll
            for (int j = 0; j < 4; ++j) { p0[j] = __shfl_xor(x[0][0][j], 32); p1[j] = __shfl_xor(x[0][1][j], 32); }
            const float sg = fq < 2 ? -1.f : 1.f;
            x[0][0] = x[0][0] * c0 + p0 * s0 * sg; x[0][1] = x[0][1] * c1 + p1 * s1 * sg;
        }
#pragma unroll
        for (int ks = 0; ks < 4; ++ks) *(LAS bf16x8*)(Qs + qt * 16 * 272 + ks * 64) = pack8(x[ks][0], x[ks][1]);
    }
    float mrun[2], lsum[2]; f32x4 O[8][2];
    { const float sk = sink[hq]; mrun[0] = sk; mrun[1] = sk; lsum[0] = fq == 0 ? 1.f : 0.f; lsum[1] = lsum[0]; }
#pragma unroll
    for (int dt = 0; dt < 8; ++dt) { O[dt][0] = (f32x4){0.f, 0.f, 0.f, 0.f}; O[dt][1] = (f32x4){0.f, 0.f, 0.f, 0.f}; }
#pragma unroll 1
    for (int j = 0; j < 3; ++j) {
        const int kb = n - 1 + j; if (kb < 0 || kb > 31) continue;
        {
            const int key = tid >> 2, qtr = tid & 3, kpos = kb * 128 + key;
            const bf16_t* kp = Z + (size_t)(b * SEQ + kpos) * NIN + C_AK + kvh * 128 + qtr * 32;
            u32x4 kr[4], vr[4];
#pragma unroll
            for (int i = 0; i < 4; ++i) { kr[i] = *(const u32x4*)(kp + i * 8); vr[i] = *(const u32x4*)(kp + (C_AV - C_AK) + i * 8); }
            f32x4 x[8]; float ss = 0.f;
#pragma unroll
            for (int i = 0; i < 4; ++i) { const u32x4 r = kr[i];
                x[2 * i] = (f32x4){lo16(r.x), hi16(r.x), lo16(r.y), hi16(r.y)}; x[2 * i + 1] = (f32x4){lo16(r.z), hi16(r.z), lo16(r.w), hi16(r.w)};
                const f32x4 q0 = x[2 * i] * x[2 * i], q1 = x[2 * i + 1] * x[2 * i + 1]; ss += (q0[0] + q0[1]) + (q0[2] + q0[3]) + (q1[0] + q1[1]) + (q1[2] + q1[3]); }
            ss += __shfl_xor(ss, 1); ss += __shfl_xor(ss, 2);
            const float rs = rsqrtf(ss * (1.0f / 128.0f) + 1e-6f);
#pragma unroll
            for (int i = 0; i < 8; ++i) x[i] *= *(const f32x4*)(kg + qtr * 32 + 4 * i) * rs;
            if (qtr == 0) {
                const float fp = (float)kpos;
#pragma unroll
                for (int i = 0; i < 4; ++i) { f32x4 c, sn;
#pragma unroll
                    for (int jj = 0; jj < 4; ++jj) { float sa, ca; hw_sincos_rev(fp * ATT_CI(4 * i + jj), sa, ca); sn[jj] = sa; c[jj] = ca; }
                    const f32x4 xa = x[i], xb = x[i + 4]; x[i] = xa * c - xb * sn; x[i + 4] = xb * c + xa * sn; }
            }
#pragma unroll
            for (int i = 0; i < 4; ++i) *(LAS bf16x8*)(Ks + key * 272 + qtr * 64 + i * 16) = pack8(x[2 * i], x[2 * i + 1]);
#pragma unroll
            for (int i = 0; i < 4; ++i) *(LAS u32x4*)(Vs + key * 288 + qtr * 64 + i * 16) = vr[i];
        }
        __syncthreads();
        const int msg = (j == 0) ? 1 : ((j == 2) ? -1 : 0);
        f32x4 S[8][2];
        {
            bf16x8 qfr[2][4];
#pragma unroll
            for (int qt = 0; qt < 2; ++qt)
#pragma unroll
                for (int ks = 0; ks < 4; ++ks) qfr[qt][ks] = *(const LAS bf16x8*)(Qs + qt * 16 * 272 + ks * 64);
#pragma unroll
            for (int kt = 0; kt < 8; ++kt) {
                bf16x8 kf[4];
#pragma unroll
                for (int ks = 0; ks < 4; ++ks) kf[ks] = *(const LAS bf16x8*)(Ks + (kt * 16 + fr) * 272 + (ks * 32 + 8 * fq) * 2);
#pragma unroll
                for (int qt = 0; qt < 2; ++qt) { f32x4 sacc = (f32x4){0.f, 0.f, 0.f, 0.f};
#pragma unroll
                    for (int ks = 0; ks < 4; ++ks) sacc = mfma16(kf[ks], qfr[qt][ks], sacc);
                    S[kt][qt] = sacc; }
            }
        }
#pragma unroll
        for (int qt = 0; qt < 2; ++qt) {
            const int ql = qrow0 + qt * 16 + fr; float mx = mrun[qt];
            int dbase = msg * (4 * fq - ql); asm volatile("" : "+v"(dbase), "+v"(S[7][1]));
#pragma unroll
            for (int kt = 0; kt < 8; ++kt)
#pragma unroll
                for (int r = 0; r < 4; ++r) { const int dd = dbase + msg * (kt * 16 + r); const float pen = (float)min(dd, 0) * 1e30f;
                    const float sv = S[kt][qt][r] + pen; S[kt][qt][r] = sv; mx = fmaxf(mx, sv); }
            mx = fmaxf(mx, __shfl_xor(mx, 16)); mx = fmaxf(mx, __shfl_xor(mx, 32));
            const float alpha = __expf(mrun[qt] - mx); mrun[qt] = mx; float ls = lsum[qt] * alpha;
#pragma unroll
            for (int kt = 0; kt < 8; ++kt)
#pragma unroll
                for (int r = 0; r < 4; ++r) { const float p = __expf(S[kt][qt][r] - mx); S[kt][qt][r] = p; ls += p; }
            lsum[qt] = ls;
#pragma unroll
            for (int dt = 0; dt < 8; ++dt) O[dt][qt] *= alpha;
        }
#pragma unroll
        for (int ks2 = 0; ks2 < 4; ++ks2) {
            bf16x8 pf[2];
#pragma unroll
            for (int qt = 0; qt < 2; ++qt) pf[qt] = pack8(S[2 * ks2][qt], S[2 * ks2 + 1][qt]);
#pragma unroll
            for (int dt = 0; dt < 8; ++dt) {
                LAS unsigned char* vb = Vs + (ks2 * 32 + 4 * fq + (fr >> 2)) * 288 + (dt * 16 + 4 * (lane & 3)) * 2;
                const bf16x8 vf = cat8(trr(vb), trr(vb + 16 * 288));
#pragma unroll
                for (int qt = 0; qt < 2; ++qt) O[dt][qt] = mfma16(vf, pf[qt], O[dt][qt]);
            }
        }
        __syncthreads();
    }
    {
        u32x2 gt[2][8];
#pragma unroll
        for (int qt = 0; qt < 2; ++qt)
#pragma unroll
            for (int dt = 0; dt < 8; ++dt) gt[qt][dt] = *(const u32x2*)(Z + (size_t)(tq0 + qrow0 + qt * 16 + fr) * NIN + C_AG + hq * 128 + dt * 16 + 4 * fq);
#pragma unroll
        for (int qt = 0; qt < 2; ++qt) {
            float ls = lsum[qt]; ls += __shfl_xor(ls, 16); ls += __shfl_xor(ls, 32);
            const float inv = 1.0f / ls; const int t = tq0 + qrow0 + qt * 16 + fr;
#pragma unroll
            for (int dt = 0; dt < 8; ++dt) {
                const int c = hq * 128 + dt * 16 + 4 * fq;
                const u32x2 gg = gt[qt][dt]; const f32x4 v = O[dt][qt] * inv;
                u32x2 o; o.x = cvt_pk_bf16(v[0] * lo16(gg.x), v[1] * hi16(gg.x)); o.y = cvt_pk_bf16(v[2] * lo16(gg.y), v[3] * hi16(gg.y));
                *(u32x2*)(Yc + (size_t)t * 1024 + c) = o;
            }
        }
    }
}

__device__ __forceinline__ void scan_item(const Args& a, int l, int it, LAS unsigned char* lds, int tid) {
    const bf16_t* Z = (const bf16_t*)(a.ws + WS_Z);
    const int lane = tid & 63, wave = tid >> 6, fr = lane & 15, fq = lane >> 4;
    const int dsl = it & 3, dir = (it >> 2) & 1, bh = it >> 3, b = bh >> 2, h = bh & 3;
    bf16_t* ST = (bf16_t*)(a.ws + (dir ? WS_SB : WS_SF)) + (size_t)bh * 32 * 65536;
    const float lg = -expf(a.in[dir ? 4 : 3][l * 4 + h]); const float dec = expf(lg * 128.f);
    LAS unsigned char* Ks = lds; LAS unsigned char* Vs = lds + 20480;
    f32x4 st[4][2];
#pragma unroll
    for (int dt = 0; dt < 4; ++dt) { st[dt][0] = (f32x4){0.f, 0.f, 0.f, 0.f}; st[dt][1] = (f32x4){0.f, 0.f, 0.f, 0.f}; }
    u32x4 vrA[8], krA[2], vrB[8], krB[2];
    const bf16_t* zb = Z + (size_t)(b * SEQ) * NIN + h * 256;
#define SCAN_LOAD(vreg, kreg, nn) do { const bf16_t* zc = zb + (size_t)((nn) * 128) * NIN; \
        _Pragma("unroll") for (int i = 0; i < 8; ++i) { const int c = tid + 512 * i; vreg[i] = *(const u32x4*)(zc + (size_t)(c >> 5) * NIN + C_RV + (c & 31) * 8); } \
        _Pragma("unroll") for (int i = 0; i < 2; ++i) { const int c = tid + 512 * i; kreg[i] = *(const u32x4*)(zc + (size_t)(c >> 3) * NIN + C_RK + dsl * 64 + (c & 7) * 8); } } while (0)
#define SCAN_STEP(vreg, kreg, step) do { \
        const int n = dir ? 31 - (step) : (step); \
        _Pragma("unroll") for (int i = 0; i < 8; ++i) { const int c = tid + 512 * i; *(LAS u32x4*)(Vs + (c >> 5) * 544 + (c & 31) * 16) = vreg[i]; } \
        _Pragma("unroll") for (int i = 0; i < 2; ++i) { const int c = tid + 512 * i, row = c >> 3; const float w = dir ? __expf(lg * (float)row) : __expf(lg * (float)(127 - row)); \
            const u32x4 r = kreg[i]; u32x4 o; o.x = cvt_pk_bf16(lo16(r.x) * w, hi16(r.x) * w); o.y = cvt_pk_bf16(lo16(r.y) * w, hi16(r.y) * w); o.z = cvt_pk_bf16(lo16(r.z) * w, hi16(r.z) * w); o.w = cvt_pk_bf16(lo16(r.w) * w, hi16(r.w) * w); \
            *(LAS u32x4*)(Ks + row * 160 + (c & 7) * 16) = o; } \
        __syncthreads(); \
        if ((step) + 2 < 32) SCAN_LOAD(vreg, kreg, dir ? 29 - (step) : (step) + 2); \
        bf16_t* so = ST + (size_t)n * 65536; \
        _Pragma("unroll") for (int dt = 0; dt < 4; ++dt) \
            _Pragma("unroll") for (int e2 = 0; e2 < 2; ++e2) { const int e = (2 * wave + e2) * 16 + fr, d = dsl * 64 + dt * 16 + 4 * fq; const f32x4 v = st[dt][e2]; \
                u32x2 o; o.x = cvt_pk_bf16(v[0], v[1]); o.y = cvt_pk_bf16(v[2], v[3]); *(u32x2*)(so + (size_t)e * 256 + d) = o; st[dt][e2] = v * dec; } \
        _Pragma("unroll") for (int ks2 = 0; ks2 < 4; ++ks2) { \
            const int krow = ks2 * 32 + 4 * fq + (fr >> 2); \
            bf16x8 af[4], bfr[2]; \
            _Pragma("unroll") for (int dt = 0; dt < 4; ++dt) { LAS unsigned char* p = Ks + krow * 160 + (dt * 16 + 4 * (lane & 3)) * 2; af[dt] = cat8(trr(p), trr(p + 16 * 160)); } \
            _Pragma("unroll") for (int e2 = 0; e2 < 2; ++e2) { LAS unsigned char* p = Vs + krow * 544 + ((2 * wave + e2) * 16 + 4 * (lane & 3)) * 2; bfr[e2] = cat8(trr(p), trr(p + 16 * 544)); } \
            _Pragma("unroll") for (int dt = 0; dt < 4; ++dt) \
                _Pragma("unroll") for (int e2 = 0; e2 < 2; ++e2) st[dt][e2] = mfma16(af[dt], bfr[e2], st[dt][e2]); } \
        __syncthreads(); } while (0)
    SCAN_LOAD(vrA, krA, dir ? 31 : 0);
    SCAN_LOAD(vrB, krB, dir ? 30 : 1);
#pragma unroll 1
    for (int step = 0; step < 32; step += 2) {
        SCAN_STEP(vrA, krA, step);
        SCAN_STEP(vrB, krB, step + 1);
    }
#undef SCAN_STEP
#undef SCAN_LOAD
}

__device__ __forceinline__ void rout_item(const Args& a, int l, int it, LAS unsigned char* lds, int tid) {
    const bf16_t* Z = (const bf16_t*)(a.ws + WS_Z); bf16_t* Ya = (bf16_t*)(a.ws + WS_YA);
    const int lane = tid & 63, wave = tid >> 6, fr = lane & 15, fq = lane >> 4;
    const int b = it >> 7, n = (it >> 2) & 31, h = it & 3, bh = b * 4 + h, t0 = b * SEQ + n * 128;
    const float lgf = -expf(a.in[3][l * 4 + h]), lgb = -expf(a.in[4][l * 4 + h]);
    LAS unsigned char* Ks = lds; LAS unsigned char* Vs = lds + 128 * 528;
#pragma unroll 1
    for (int i4 = 0; i4 < 2; ++i4) {
        u32x4 kr[4], vr[4];
#pragma unroll
        for (int i = 0; i < 4; ++i) { const int c = tid + 512 * (i4 * 4 + i), row = c >> 5, ch = c & 31; const bf16_t* zp = Z + (size_t)(t0 + row) * NIN + h * 256 + ch * 8;
            kr[i] = *(const u32x4*)(zp + C_RK); vr[i] = *(const u32x4*)(zp + C_RV); }
#pragma unroll
        for (int i = 0; i < 4; ++i) { const int c = tid + 512 * (i4 * 4 + i), row = c >> 5, ch = c & 31;
            *(LAS u32x4*)(Ks + row * 528 + ch * 16) = kr[i]; *(LAS u32x4*)(Vs + row * 544 + ch * 16) = vr[i]; }
    }
    const int jq = wave * 16 + fr;
    bf16x8 qf[8];
#pragma unroll
    for (int ks = 0; ks < 8; ++ks) qf[ks] = *(const bf16x8*)(Z + (size_t)(t0 + jq) * NIN + C_RQ + h * 256 + ks * 32 + 8 * fq);
    __syncthreads();
    f32x4 S[8];
#pragma unroll
    for (int kt = 0; kt < 8; ++kt) { f32x4 sacc = (f32x4){0.f, 0.f, 0.f, 0.f};
#pragma unroll
        for (int ks = 0; ks < 8; ++ks) sacc = mfma16(*(const LAS bf16x8*)(Ks + (kt * 16 + fr) * 528 + (ks * 32 + 8 * fq) * 2), qf[ks], sacc);
        S[kt] = sacc; }
    {
        int lb = jq - 4 * fq; asm volatile("" : "+v"(lb), "+v"(S[7]));
#pragma unroll
        for (int kt = 0; kt < 8; ++kt)
#pragma unroll
            for (int r = 0; r < 4; ++r) { const float fl = (float)(lb - (kt * 16 + r)); S[kt][r] *= __expf(fmaxf(fl, 0.f) * lgf + fmaxf(-fl, 0.f) * lgb); }
    }
    f32x4 O[16];
#pragma unroll
    for (int dt = 0; dt < 16; ++dt) O[dt] = (f32x4){0.f, 0.f, 0.f, 0.f};
#pragma unroll
    for (int ks2 = 0; ks2 < 4; ++ks2) {
        const bf16x8 pf = pack8(S[2 * ks2], S[2 * ks2 + 1]);
#pragma unroll
        for (int dt = 0; dt < 16; ++dt) { LAS unsigned char* vb = Vs + (ks2 * 32 + 4 * fq + (fr >> 2)) * 544 + (dt * 16 + 4 * (lane & 3)) * 2;
            O[dt] = mfma16(cat8(trr(vb), trr(vb + 16 * 544)), pf, O[dt]); if ((dt & 3) == 3) asm volatile("" ::: "memory"); }
    }
    bf16x8 qf2[8];
    { const bf16_t* qp2 = Z + (size_t)(t0 + jq) * NIN + C_RQ + h * 256 + 8 * fq; asm volatile("" : "+v"(qp2));
#pragma unroll
      for (int ks = 0; ks < 8; ++ks) qf2[ks] = *(const bf16x8*)(qp2 + ks * 32); }
    __syncthreads();
#pragma unroll 1
    for (int dir = 0; dir < 2; ++dir) {
        if ((dir == 0 && n == 0) || (dir == 1 && n == 31)) continue;
        const bf16_t* ST = (const bf16_t*)(a.ws + (dir ? WS_SB : WS_SF)) + ((size_t)bh * 32 + n) * 65536;
#pragma unroll 1
        for (int hh = 0; hh < 2; ++hh) {
            u32x4 sreg[8];
#pragma unroll
            for (int i = 0; i < 8; ++i) { const int c = tid + 512 * (i + 8 * hh); sreg[i] = *(const u32x4*)(ST + (size_t)(c >> 5) * 256 + (c & 31) * 8); }
#pragma unroll
            for (int i = 0; i < 8; ++i) { const int c = tid + 512 * (i + 8 * hh); *(LAS u32x4*)(lds + (c >> 5) * 528 + (c & 31) * 16) = sreg[i]; }
        }
        __syncthreads();
        const float sc = dir ? __expf(lgb * (float)(128 - jq)) : __expf(lgf * (float)(jq + 1));
#pragma unroll
        for (int dt = 0; dt < 16; ++dt) { f32x4 tacc = (f32x4){0.f, 0.f, 0.f, 0.f};
#pragma unroll
            for (int ks = 0; ks < 8; ++ks) tacc = mfma16(*(const LAS bf16x8*)(lds + (dt * 16 + fr) * 528 + (ks * 32 + 8 * fq) * 2), qf2[ks], tacc);
            O[dt] += tacc * sc; }
        __syncthreads();
    }
    float ss = 0.f;
#pragma unroll
    for (int dt = 0; dt < 16; ++dt) { const f32x4 q = O[dt] * O[dt]; ss += (q[0] + q[1]) + (q[2] + q[3]); }
    ss += __shfl_xor(ss, 16); ss += __shfl_xor(ss, 32);
    const float rs = rsqrtf(ss * (1.0f / 256.0f) + 1e-6f);
    {
        u32x2 gt[16];
#pragma unroll
        for (int dt = 0; dt < 16; ++dt) gt[dt] = *(const u32x2*)(Z + (size_t)(t0 + jq) * NIN + C_RG + h * 256 + dt * 16 + 4 * fq);
#pragma unroll
        for (int dt = 0; dt < 16; ++dt) { const int c = h * 256 + dt * 16 + 4 * fq; const u32x2 gg = gt[dt]; const f32x4 v = O[dt] * rs;
            u32x2 o; o.x = cvt_pk_bf16(v[0] * lo16(gg.x), v[1] * hi16(gg.x)); o.y = cvt_pk_bf16(v[2] * lo16(gg.y), v[3] * hi16(gg.y));
            *(u32x2*)(Ya + (size_t)(t0 + jq) * 1024 + c) = o; }
    }
}

__device__ __forceinline__ int next_item(unsigned* ctr, LAS int* slot, int tid) {
    __syncthreads();
    if (tid == 0) *slot = (int)atomicAdd(ctr, 1u);
    __syncthreads();
    return *slot;
}
__device__ void mix1_fast(const Args& a, int l, LAS unsigned char* lds, int cofs) {
    unsigned* ctr = (unsigned*)(a.ws + WS_CTR) + cofs + l * 4;
    LAS int* slot = (LAS int*)(lds + LDS_BYTES - 16);
#if PROBE_DUP & 256
    { const int tid = otid(); for (;;) { const int it = next_item(ctr, slot, tid); if (it >= 256) break; scan_item(a, l, it & 127, lds, tid); } }
#else
    { const int tid = otid(); for (;;) { const int it = next_item(ctr, slot, tid); if (it >= 128) break; scan_item(a, l, it, lds, tid); } }
#endif
#if PROBE_DUP & 512
    { const int tid = otid(); for (;;) { const int it = next_item(ctr + 1, slot, tid); if (it >= 1024) break; attn_item(a, l, it & 511, lds, tid); } }
#else
    { const int tid = otid(); for (;;) { const int it = next_item(ctr + 1, slot, tid); if (it >= 512) break; attn_item(a, l, it, lds, tid); } }
#endif
    { const int tid = otid(); for (;;) { const int it = next_item(ctr + 2, slot, tid); if (it >= 512) break; pool_item(a, l, it, lds, tid); } }
}
__device__ void rout_fast(const Args& a, int l, LAS unsigned char* lds, int cofs) {
    const int tid = otid();
    unsigned* ctr = (unsigned*)(a.ws + WS_CTR) + cofs + l * 4 + 3;
    LAS int* slot = (LAS int*)(lds + LDS_BYTES - 16);
    for (;;) {
        const int it = next_item(ctr, slot, tid);
        if (it >= 512) break;
        rout_item(a, l, it, lds, tid);
    }
}


#define XB_TMO      128
#define XB_XCNT(j)  (256  + 64 * (j))
#define XB_XSUB(j)  (1280 + 64 * (j))
#define XB_XGEN(j)  (2304 + 64 * (j))
#define XB_TOP      3328
#define XB_TOPGEN   3392
#define XCD_BAR_WORDS 3456
#define XB_SPIN_CAP (1u << 18)
__device__ __forceinline__ unsigned xb_ld(unsigned* p)              { return __hip_atomic_load(p, __ATOMIC_RELAXED, __HIP_MEMORY_SCOPE_AGENT); }
__device__ __forceinline__ unsigned xb_add(unsigned* p, unsigned v) { return __hip_atomic_fetch_add(p, v, __ATOMIC_RELAXED, __HIP_MEMORY_SCOPE_AGENT); }
__device__ __forceinline__ unsigned xb_xcc_id() { return (unsigned)__builtin_amdgcn_s_getreg((3 << 11) | 20) & 0xFu; }
#define XB_SPIN(cond, bar) do { unsigned _sp = 0; while (cond) { __builtin_amdgcn_s_sleep(1); \
    if ((++_sp & 255u) == 0u) { if (xb_ld(&(bar)[XB_TMO])) break; if (_sp > XB_SPIN_CAP) { atomicAdd(&(bar)[XB_TMO], 1u); break; } } } } while (0)
struct XcdBarrier { unsigned* bar; unsigned x; volatile LAS unsigned* st; };
__device__ __forceinline__ XcdBarrier xcd_barrier_post(unsigned* bar, volatile LAS unsigned* st) {
    XcdBarrier b; b.bar = bar; b.x = xb_xcc_id(); b.st = st;
    if (threadIdx.x == 0) (void)xb_add(&bar[XB_XCNT(b.x)], 1u);
    return b;
}
__device__ __forceinline__ void xcd_barrier_complete(unsigned* bar, unsigned x, unsigned& nloc, unsigned& nx) {
    const unsigned G = gridDim.x * gridDim.y * gridDim.z;
    unsigned sum, cnt, mine, sp = 0u;
    for (;;) {
        sum = 0u; cnt = 0u; mine = 0u;
#pragma unroll
        for (unsigned j = 0; j < 16; ++j) { const unsigned c = xb_ld(&bar[XB_XCNT(j)]); sum += c; cnt += (c > 0u) ? 1u : 0u; mine = (j == x) ? c : mine; }
        if (sum == G) break;
        __builtin_amdgcn_s_sleep(1);
        if ((++sp & 255u) == 0u) { if (xb_ld(&bar[XB_TMO])) break; if (sp > XB_SPIN_CAP) { atomicAdd(&bar[XB_TMO], 1u); break; } }
    }
    nloc = mine > 0u ? mine : 1u; nx = cnt > 0u ? cnt : 1u;
}
__device__ __forceinline__ void xcd_barrier(const XcdBarrier& b) {
    asm volatile("s_waitcnt vmcnt(0)" ::: "memory");
    __syncthreads();
    if (threadIdx.x == 0) {
        unsigned* bar = b.bar;
        __builtin_amdgcn_s_waitcnt(0);
        unsigned nloc = b.st[0], nx = b.st[1];
        if (nloc == 0u) { xcd_barrier_complete(bar, b.x, nloc, nx); b.st[0] = nloc; b.st[1] = nx; }
        const unsigned old = xb_add(&bar[XB_XSUB(b.x)], 1u);
        const unsigned gen = old / nloc;
        if (old + 1u == (gen + 1u) * nloc) {
            __builtin_amdgcn_fence(__ATOMIC_RELEASE, "agent");
            asm volatile("s_waitcnt vmcnt(0)" ::: "memory");
            const unsigned og = xb_add(&bar[XB_TOP], 1u);
            const unsigned tg = og / nx;
            if (og + 1u == (tg + 1u) * nx) xb_add(&bar[XB_TOPGEN], 1u);
            else XB_SPIN(xb_ld(&bar[XB_TOPGEN]) == tg, bar);
            __builtin_amdgcn_fence(__ATOMIC_ACQUIRE, "agent");
            xb_add(&bar[XB_XGEN(b.x)], 1u);
            asm volatile("s_waitcnt vmcnt(0)" ::: "memory");
        } else {
            XB_SPIN(xb_ld(&bar[XB_XGEN(b.x)]) == gen, bar);
            __builtin_amdgcn_fence(__ATOMIC_ACQUIRE, "agent");
            asm volatile("s_waitcnt vmcnt(0)" ::: "memory");
        }
    }
    __syncthreads();
}

constexpr int N_PHASES = 1 + 5 * DEPTH;

__global__ void __launch_bounds__(NTHR, 2) mk_fwd(Args a) {
    extern __shared__ __attribute__((aligned(16))) unsigned char lds_raw[];
    LAS unsigned char* lds = (LAS unsigned char*)lds_raw;
    float* ldsf = (float*)lds_raw;
    unsigned char* ws = a.ws;
    const int lo = a.ph_lo, hi = a.ph_hi;
#ifndef PHMASK
#define PHMASK 0xff
#endif
#define IN(k) (lo <= (k) && (k) < hi)
    volatile LAS unsigned* xst = (volatile LAS unsigned*)(lds + LDS_BYTES - 32);
    if (threadIdx.x < 2) xst[threadIdx.x] = 0u;
    __syncthreads();
#define SEAM(k) do { if (IN(k) && IN((k) + 1)) { if ((k) == 0) { cg::this_grid().sync(); (void)xcd_barrier_post((unsigned*)(a.ws + WS_BAR), xst); } else { XcdBarrier xb_; xb_.bar = (unsigned*)(a.ws + WS_BAR); xb_.x = xb_xcc_id(); xb_.st = xst; xcd_barrier(xb_); } } } while (0)
    if ((PHMASK & 1) && IN(0)) { prologue(a, ldsf);
#if PROBE_DUP & 1
        prologue(a, ldsf);
#endif
    }
    SEAM(0);
    for (int l = 0; l < DEPTH; ++l) {
        const int pb = 1 + 5 * l;
        if ((PHMASK & 2) && IN(pb)) {
            int pm0, pn0_; pg8::tile_order((long)blockIdx.x, T_TOK / 256, NIN / 256, pm0, pn0_);
            LAS float* rsl = (LAS float*)(lds + 131072);
            {
                const int t = otid();
                if (t < 256) { const f32x4* rp = (const f32x4*)((const float*)(ws + WS_ROWSS) + (size_t)(pm0 * 256 + t) * 32);
                    f32x4 p[8];
#pragma unroll
                    for (int q = 0; q < 8; ++q) p[q] = rp[q];
                    float sk[4];
#pragma unroll
                    for (int q = 0; q < 4; ++q) { const f32x4 t4 = p[2 * q] + p[2 * q + 1]; sk[q] = (t4[0] + t4[1]) + (t4[2] + t4[3]); }
                    rsl[t] = rsqrtf(((sk[0] + sk[1]) + (sk[2] + sk[3])) * (1.0f / DM) + 1e-6f); }
                __syncthreads();
            }
            InProj S{(const bf16_t*)(ws + WS_XB), (const bf16_t*)(ws + WS_WIN + l * SZ_WIN), (bf16_t*)(ws + WS_Z), (const float*)(ws + WS_ROWSS),
                     (const float*)(ws + WS_COSR), (const float*)(ws + WS_SINR), (int)gridDim.x, (int)blockIdx.x, pm0, rsl};
            pg8::gemm_phase<InProj>(lds, DM, S);
#if PROBE_DUP & 8
            pg8::gemm_phase<InProj>(lds, DM, S);
#endif
        }
        SEAM(pb);
        if (IN(pb + 1)) {
#if FAST_MIX
            if (PHMASK & 4) mix1_fast(a, l, lds, 0);
#if PROBE_DUP & 2
            mix1_fast(a, l, lds, 32);
#endif
#else
            if (PHMASK & 4) ret_scan_naive(a, l);
            if (PHMASK & 8) attn_naive(a, l, ldsf);
            if (PHMASK & 16) pool_naive(a, l, ldsf);
#endif
        }
        SEAM(pb + 1);
        #if FAST_ROUT
        if ((PHMASK & 32) && IN(pb + 2)) { rout_fast(a, l, lds, 0);
#if PROBE_DUP & 4
            rout_fast(a, l, lds, 32);
#endif
        }
#else
        if ((PHMASK & 32) && IN(pb + 2)) { ret_out_naive(a, l, ldsf); }
#endif
        SEAM(pb + 2);
        if ((PHMASK & 64) && IN(pb + 3)) {
            MergeP S{(const bf16_t*)(ws + WS_YA), (const bf16_t*)(ws + WS_WRET + l * SZ_WBR),
                     (const bf16_t*)(ws + WS_Z), (bf16_t*)(ws + WS_MG), (int)gridDim.x, (int)blockIdx.x};
            pg8::gemm_phase<MergeP>(lds, 1024, S);
#if PROBE_DUP & 16
            pg8::gemm_phase<MergeP>(lds, 1024, S);
#endif
        }
        SEAM(pb + 3);
        if ((PHMASK & 128) && IN(pb + 4)) {
            OutProj S{(const bf16_t*)(ws + WS_MG), (const bf16_t*)(ws + WS_WOUT + l * SZ_WOUT), l == 0 ? a.in[0] : a.out, a.out, (bf16_t*)(ws + WS_XB),
                      l + 1 < DEPTH ? (float*)(ws + WS_ROWSS) : nullptr, (int)gridDim.x, (int)blockIdx.x};
            pg8::gemm_phase<OutProj>(lds, DM, S);
#if PROBE_DUP & 64
            if (l == 0) { pg8::gemm_phase<OutProj>(lds, DM, S); pg8::gemm_phase<OutProj>(lds, DM, S); }
#endif
        }
        SEAM(pb + 4);
    }
#undef IN
#undef SEAM
}

extern "C" void kernel_launch(void* const* d_in, const int* in_sizes, int n_in, void* d_out, int out_size, void* d_ws, size_t ws_size, hipStream_t stream) {
    static int grid = 0;
    if (grid == 0) {
        if (n_in != 14 || out_size != T_TOK * DM || ws_size < WS_END) { fprintf(stderr, "kernel_launch: unexpected shapes (n_in %d out %d ws %zu need %zu)\n", n_in, out_size, ws_size, (size_t)WS_END); grid = -1; return; }
        int dev = 0, cus = 0, per_cu = 0;
        hipGetDevice(&dev); hipDeviceGetAttribute(&cus, hipDeviceAttributeMultiprocessorCount, dev);
        if (hipFuncSetAttribute((const void*)mk_fwd, hipFuncAttributeMaxDynamicSharedMemorySize, LDS_BYTES) != hipSuccess) { fprintf(stderr, "kernel_launch: hipFuncSetAttribute failed\n"); grid = -1; return; }
        if (hipOccupancyMaxActiveBlocksPerMultiprocessor(&per_cu, (const void*)mk_fwd, NTHR, LDS_BYTES) != hipSuccess || per_cu < 1) { fprintf(stderr, "kernel_launch: occupancy query says %d\n", per_cu); per_cu = 1; }
        (void)hipGetLastError();
        grid = cus * 1;
    }
    if (grid < 0) return;
    Args a{};
    for (int i = 0; i < 14; ++i) a.in[i] = (const float*)d_in[i];
    a.out = (float*)d_out; a.ws = (unsigned char*)d_ws;
#if ONE_LAUNCH
    a.ph_lo = 0; a.ph_hi = N_PHASES;
    void* args[] = {&a};
    hipError_t e = hipLaunchCooperativeKernel((const void*)mk_fwd, dim3(grid), dim3(NTHR), args, LDS_BYTES, stream);
    if (e != hipSuccess) fprintf(stderr, "cooperative launch failed: %s (grid %d)\n", hipGetErrorString(e), grid);
#else
    for (int p = 0; p < N_PHASES; ++p) {
        a.ph_lo = p; a.ph_hi = p + 1;
        hipLaunchKernelGGL(mk_fwd, dim3(grid), dim3(NTHR), LDS_BYTES, stream, a);
    }
#endif
}
```

```cpp
#include <hip/hip_runtime.h>
#include <hip/hip_cooperative_groups.h>
#include <cstdio>
namespace cg = cooperative_groups;

#ifndef FAST_MIX
#define FAST_MIX 1
#endif
#ifndef FAST_ROUT
#define FAST_ROUT 1
#endif
#ifndef PROBE_DUP
#define PROBE_DUP 0
#endif
#ifndef ONE_LAUNCH
#define ONE_LAUNCH 1
#endif

#define LAS __attribute__((address_space(3)))
typedef unsigned short bf16_t;
typedef short bf16x8 __attribute__((ext_vector_type(8)));
typedef float f32x4 __attribute__((ext_vector_type(4)));
typedef unsigned u32x4 __attribute__((ext_vector_type(4)));
typedef unsigned u32x2 __attribute__((ext_vector_type(2)));

constexpr int T_TOK = 16384, DM = 2048, NIN = 14848, SEQ = 4096, DEPTH = 4;
constexpr int C_RQ = 0, C_RK = 1024, C_RV = 2048, C_RG = 3072, C_PV = 4096, C_PG = 5120, C_AQ = 6144, C_AK = 7168, C_AV = 7424, C_AG = 7680, C_MG = 8704;
constexpr int NTHR = 512;
constexpr int LDS_BYTES = 147456;

constexpr size_t SZ_WIN = (size_t)NIN * DM * 2, SZ_WBR = (size_t)DM * 1024 * 2, SZ_WOUT = (size_t)DM * DM * 2, SZ_PW = (size_t)4 * 256 * 256 * 2;
constexpr size_t WS_WIN = 0;
constexpr size_t WS_WRET = WS_WIN + DEPTH * SZ_WIN;
constexpr size_t WS_WPOOL = WS_WRET + DEPTH * SZ_WBR;
constexpr size_t WS_WATT = WS_WPOOL + DEPTH * SZ_WBR;
constexpr size_t WS_WOUT = WS_WATT + DEPTH * SZ_WBR;
constexpr size_t WS_PW = WS_WOUT + DEPTH * SZ_WOUT;
constexpr size_t WS_XB = WS_PW + DEPTH * SZ_PW;
constexpr size_t WS_Z = WS_XB + (size_t)T_TOK * DM * 2;
constexpr size_t WS_ROWSS = WS_Z + (size_t)T_TOK * NIN * 2;
constexpr size_t WS_SF = WS_ROWSS + (size_t)T_TOK * 32 * 4;
constexpr size_t SZ_ST = (size_t)16 * 32 * 65536 * 2;
constexpr size_t WS_SB = WS_SF + SZ_ST;
constexpr size_t WS_YA = WS_SB + SZ_ST;
constexpr size_t SZ_Y = (size_t)T_TOK * 1024 * 2;
constexpr size_t WS_YB = WS_YA + SZ_Y;
constexpr size_t WS_YC = WS_YB + SZ_Y;
constexpr size_t WS_MG = WS_YC + SZ_Y;
constexpr size_t WS_COSR = WS_MG + (size_t)T_TOK * DM * 2;
constexpr size_t WS_SINR = WS_COSR + (size_t)SEQ * 128 * 4;
constexpr size_t WS_COSA = WS_SINR + (size_t)SEQ * 128 * 4;
constexpr size_t WS_SINA = WS_COSA + (size_t)SEQ * 16 * 4;
constexpr size_t WS_CTR = WS_SINA + (size_t)SEQ * 16 * 4;
constexpr size_t WS_BAR = WS_CTR + 256;
constexpr size_t WS_END = WS_BAR + 16384;

struct Args { const float* in[14]; float* out; unsigned char* ws; int ph_lo, ph_hi; };

__device__ __forceinline__ float bf2f(bf16_t b) { return __uint_as_float(((unsigned)b) << 16); }
__device__ __forceinline__ unsigned cvt_pk_bf16(float lo, float hi) { unsigned r; asm volatile("v_cvt_pk_bf16_f32 %0, %1, %2" : "=v"(r) : "v"(lo), "v"(hi)); return r; }
__device__ __forceinline__ bf16_t f2bf(float f) { return (bf16_t)(cvt_pk_bf16(f, 0.f) & 0xffffu); }
__device__ __forceinline__ float lo16(unsigned w) { return __uint_as_float(w << 16); }
__device__ __forceinline__ float hi16(unsigned w) { return __uint_as_float(w & 0xffff0000u); }
__device__ __forceinline__ float wave_sum(float v) {
#pragma unroll
    for (int o = 32; o >= 1; o >>= 1) v += __shfl_xor(v, o);
    return v;
}
__device__ __forceinline__ float wave_max(float v) {
#pragma unroll
    for (int o = 32; o >= 1; o >>= 1) v = fmaxf(v, __shfl_xor(v, o));
    return v;
}
__device__ __forceinline__ int otid() { int t = threadIdx.x; asm volatile("" : "+v"(t)); return t; }
__device__ __forceinline__ void hw_sincos_rev(float rev, float& sn, float& cs) { const float f = __builtin_amdgcn_fractf(rev); sn = __builtin_amdgcn_sinf(f); cs = __builtin_amdgcn_cosf(f); }
__device__ __forceinline__ float silu_f(float v) { return v * __builtin_amdgcn_rcpf(1.f + __expf(-v)); }
__device__ __forceinline__ float sigm_f(float v) { return __builtin_amdgcn_rcpf(1.f + __expf(-v)); }
__device__ __forceinline__ void sincos_red(float ang, float& s, float& c) {
    const double a = (double)ang; const double k = rint(a * 0.15915494309189535); const float r = (float)(a - k * 6.283185307179586);
    s = sinf(r); c = cosf(r);
}

namespace pg8 {
constexpr int BM = 256, BK = 64, HALF = 128, HTB = HALF * BK * 2, STAGE_BYTES = 8 * HTB, NXCD = 8, WGM = 8;
__device__ __forceinline__ int lds_byte(int r, int c) { const int st = (r >> 4) * 2 + (c >> 5), rr = r & 15, cc = c & 31, ob = rr * 64 + cc * 2; return st * 1024 + (ob ^ (((ob >> 9) & 1) << 5)); }
__device__ __forceinline__ void stage_rc(int b, int& R, int& C) { const int st = b / 1024, sb = b % 1024, swz = sb ^ (((sb >> 9) & 1) << 5); R = (st >> 1) * 16 + swz / 64; C = (st & 1) * 32 + (swz % 64) / 2; }
__device__ __forceinline__ int perm32(int rho) { const int n = rho >> 4, i = rho & 15; return 8 * (i >> 2) + 4 * n + (i & 3); }
struct Unit { const char* a; const char* b; int pm, pn, sub; };
__device__ __forceinline__ bool tile_order(long L, int nM, int nN, int& pm, int& pn) {
    const int nwg = nM * nN; if (L >= nwg) return false;
    int wgid = (int)L; { const int q = nwg / NXCD, r = nwg % NXCD, xcd = wgid % NXCD, off = wgid / NXCD; wgid = (xcd < r ? xcd * (q + 1) : r * (q + 1) + (xcd - r) * q) + off; }
    const int nig = WGM * nN, gid = wgid / nig, fm = gid * WGM, gsz = (nM - fm) < WGM ? (nM - fm) : WGM;
    pm = fm + ((wgid % nig) % gsz); pn = (wgid % nig) / gsz; return true;
}
template <class Prog>
__device__ __forceinline__ void gemm_phase(LAS unsigned char* lds, const int K, const Prog& S) {
    int tid_ = threadIdx.x; asm volatile("" : "+v"(tid_));
    const int tid = tid_, wid = __builtin_amdgcn_readfirstlane(tid >> 6), lane = tid & 63, wr = wid >> 2, wc = wid & 3, fr = lane & 15, fq = lane >> 4;
    const int nt = K / BK;
    unsigned voffA[2], voffB[2];
#pragma unroll
    for (int i = 0; i < 2; ++i) { int R, C; stage_rc(tid * 16 + i * 8192, R, C); const int Rb = Prog::PERM ? ((R & ~31) + perm32(R & 31)) : R;
        voffA[i] = (unsigned)(R * K + C) * 2u; voffB[i] = (unsigned)(Rb * K + C) * 2u; }
    const size_t kstep = (size_t)(BK * 2);
    const size_t hstep = (size_t)HALF * K * 2;
    const unsigned ldsw = (unsigned)wid * 1024u;
    const int aoff = lds_byte(wr * 64 + fr, fq * 8), boff = lds_byte(wc * 32 + fr, fq * 8);
#define PG8_SA(b, h) (((b) * 2 + (h)) * HTB)
#define PG8_SB(b, h) ((4 + (b) * 2 + (h)) * HTB)
#define PG8_STAGE(bufoff, gbase, voff) do { _Pragma("unroll") for (int _i = 0; _i < 2; ++_i) \
        __builtin_amdgcn_global_load_lds((const unsigned*)((const char*)(gbase) + (voff)[_i]), (LAS unsigned*)(lds + (bufoff) + ldsw + _i * 8192), 16, 0, 0); } while (0)
#define PG8_LDA(dst, b, h) do { _Pragma("unroll") for (int m = 0; m < 4; ++m) _Pragma("unroll") for (int k = 0; k < 2; ++k) dst[m][k] = *(const LAS bf16x8*)(lds + PG8_SA(b, h) + aoff + m * 2048 + k * 1024); } while (0)
#define PG8_LDB(dst, b, h) do { _Pragma("unroll") for (int n = 0; n < 2; ++n) _Pragma("unroll") for (int k = 0; k < 2; ++k) dst[n][k] = *(const LAS bf16x8*)(lds + PG8_SB(b, h) + boff + n * 2048 + k * 1024); } while (0)
#define PG8_MMA(ai, bj, At, Bt) do { __builtin_amdgcn_s_setprio(1); _Pragma("unroll") for (int m = 0; m < 4; ++m) _Pragma("unroll") for (int n = 0; n < 2; ++n) _Pragma("unroll") for (int k = 0; k < 2; ++k) \
        acc[ai][bj][m][n] = __builtin_amdgcn_mfma_f32_16x16x32_bf16(Bt[n][k], At[m][k], acc[ai][bj][m][n], 0, 0, 0); __builtin_amdgcn_s_setprio(0); } while (0)
#define PG8_WAIT_V(n) asm volatile("s_waitcnt vmcnt(" #n ")" ::: "memory")
#define PG8_WAIT_L(n) asm volatile("s_waitcnt lgkmcnt(" #n ")" ::: "memory")
#define PG8_BAR __builtin_amdgcn_s_barrier()
#define PG8_SCHED __builtin_amdgcn_sched_barrier(0)
    Unit cur, nxt; int ui = 0;
    if (!S.next(0, cur)) return;
    f32x4 acc[2][2][4][2];
#pragma unroll
    for (int a = 0; a < 2; ++a)
#pragma unroll
        for (int b = 0; b < 2; ++b)
#pragma unroll
            for (int m = 0; m < 4; ++m)
#pragma unroll
                for (int n = 0; n < 2; ++n) acc[a][b][m][n] = (f32x4){0.f, 0.f, 0.f, 0.f};
    bf16x8 At[4][2], B0[2][2], B1[2][2];
    const char* cA = cur.a; const char* cB = cur.b;
    PG8_STAGE(PG8_SB(0, 0), cB, voffB); PG8_STAGE(PG8_SA(0, 0), cA, voffA); PG8_STAGE(PG8_SB(0, 1), cB + hstep, voffB); PG8_STAGE(PG8_SA(0, 1), cA + hstep, voffA);
    if (wr == 1) PG8_BAR;
    PG8_WAIT_V(4); PG8_BAR;
    PG8_STAGE(PG8_SB(1, 0), cB + kstep, voffB); PG8_STAGE(PG8_SA(1, 0), cA + kstep, voffA); PG8_STAGE(PG8_SB(1, 1), cB + hstep + kstep, voffB);
    PG8_WAIT_V(6); PG8_BAR;
    for (;;) {
        const bool has_next = S.next(ui + 1, nxt);
        const char* nA = has_next ? nxt.a : cA; const char* nB = has_next ? nxt.b : cB;
        for (int t = 0; t < nt; t += 2) {
            const bool last = (t == nt - 2);
            const char* a1 = cA + (size_t)(t + 1) * kstep;
            const char* a2 = last ? nA : cA + (size_t)(t + 2) * kstep; const char* b2 = last ? nB : cB + (size_t)(t + 2) * kstep;
            const char* a3 = a2 + kstep; const char* b3 = b2 + kstep;
            PG8_LDB(B0, 0, 0); PG8_SCHED; PG8_LDA(At, 0, 0); PG8_STAGE(PG8_SA(1, 1), a1 + hstep, voffA);
            PG8_WAIT_L(8); PG8_BAR; PG8_WAIT_L(0); PG8_MMA(0, 0, At, B0); PG8_BAR; PG8_SCHED;
            PG8_LDB(B1, 0, 1); PG8_STAGE(PG8_SB(0, 0), b2, voffB);
            PG8_BAR; PG8_WAIT_L(0); PG8_MMA(0, 1, At, B1); PG8_BAR;
            PG8_LDA(At, 0, 1); PG8_STAGE(PG8_SA(0, 0), a2, voffA);
            PG8_BAR; PG8_WAIT_L(0); PG8_MMA(1, 0, At, B0); PG8_BAR; PG8_SCHED;
            PG8_STAGE(PG8_SB(0, 1), b2 + hstep, voffB);
            PG8_WAIT_V(6); PG8_BAR; PG8_MMA(1, 1, At, B1); PG8_BAR;
            PG8_LDB(B0, 1, 0); PG8_SCHED; PG8_LDA(At, 1, 0); PG8_STAGE(PG8_SA(0, 1), a2 + hstep, voffA);
            PG8_WAIT_L(8); PG8_BAR; PG8_WAIT_L(0); PG8_MMA(0, 0, At, B0); PG8_BAR; PG8_SCHED;
            PG8_LDB(B1, 1, 1); PG8_STAGE(PG8_SB(1, 0), b3, voffB);
            PG8_BAR; PG8_WAIT_L(0); PG8_MMA(0, 1, At, B1); PG8_BAR;
            PG8_LDA(At, 1, 1); PG8_STAGE(PG8_SA(1, 0), a3, voffA);
            PG8_BAR; PG8_WAIT_L(0); PG8_MMA(1, 0, At, B0); PG8_BAR; PG8_SCHED;
            PG8_STAGE(PG8_SB(1, 1), b3 + hstep, voffB);
            PG8_WAIT_V(6); PG8_BAR; PG8_MMA(1, 1, At, B1); PG8_BAR;
        }
        S.epi(acc, cur, wr, wc, fr, fq);
        if (!S.keep(cur)) {
#pragma unroll
            for (int a = 0; a < 2; ++a)
#pragma unroll
                for (int b = 0; b < 2; ++b)
#pragma unroll
                    for (int m = 0; m < 4; ++m)
#pragma unroll
                        for (int n = 0; n < 2; ++n) acc[a][b][m][n] = (f32x4){0.f, 0.f, 0.f, 0.f};
        }
        if (!has_next) break;
        cur = nxt; cA = nA; cB = nB; ++ui;
    }
    PG8_WAIT_V(0);
    if (wr == 0) PG8_BAR;
    PG8_BAR;
#undef PG8_SA
#undef PG8_SB
#undef PG8_STAGE
#undef PG8_LDA
#undef PG8_LDB
#undef PG8_MMA
#undef PG8_WAIT_V
#undef PG8_WAIT_L
#undef PG8_BAR
#undef PG8_SCHED
}
}

struct InProj {
    static constexpr bool PERM = true;
    const bf16_t* A; const bf16_t* Bt; bf16_t* Z; const float* rowss; const float* cosR; const float* sinR; int G, c;
    int pm0; const LAS float* rsl;
    __device__ __forceinline__ bool next(int i, pg8::Unit& u) const {
        if (!pg8::tile_order((long)i * G + c, T_TOK / 256, NIN / 256, u.pm, u.pn)) return false;
        u.a = (const char*)(A + (size_t)u.pm * 256 * DM); u.b = (const char*)(Bt + (size_t)u.pn * 256 * DM); u.sub = 0; return true;
    }
    __device__ __forceinline__ bool keep(const pg8::Unit&) const { return false; }
    __device__ __forceinline__ void epi(f32x4 (&acc)[2][2][4][2], const pg8::Unit& u, int wr, int wc, int fr, int fq) const {
        const int row0 = u.pm * 256 + wr * 64 + fr, col0 = u.pn * 256 + wc * 32 + 8 * fq;
        const int pn = u.pn;
        const int mode = (pn < 8) ? 1 : ((pn >= 12 && pn < 16) || (pn >= 20 && pn < 24) || (pn >= 30 && pn < 34)) ? 2 : (pn >= 34 ? 3 : 0);
        const float ksc = (pn >= 4 && pn < 8) ? 0.0625f : 1.0f;
        float rsv[2][4];
        if (u.pm == pm0) {
#pragma unroll
            for (int ai = 0; ai < 2; ++ai)
#pragma unroll
                for (int m = 0; m < 4; ++m) rsv[ai][m] = rsl[ai * 128 + wr * 64 + m * 16 + fr];
        } else {
            f32x4 pa[2][4], pb[2][4];
#pragma unroll
            for (int ai = 0; ai < 2; ++ai)
#pragma unroll
                for (int m = 0; m < 4; ++m) { const f32x4* rp = (const f32x4*)(rowss + (size_t)(row0 + ai * 128 + m * 16) * 32) + fq * 2; pa[ai][m] = rp[0]; pb[ai][m] = rp[1]; }
#pragma unroll
            for (int ai = 0; ai < 2; ++ai)
#pragma unroll
                for (int m = 0; m < 4; ++m) { const f32x4 t4 = pa[ai][m] + pb[ai][m]; float sm = (t4[0] + t4[1]) + (t4[2] + t4[3]); sm += __shfl_xor(sm, 16); sm += __shfl_xor(sm, 32);
                    rsv[ai][m] = rsqrtf(sm * (1.0f / DM) + 1e-6f); }
        }
        if (mode == 1) {
            f32x4 ci[2];
#pragma unroll
            for (int n = 0; n < 2; ++n)
#pragma unroll
                for (int j = 0; j < 4; ++j) ci[n][j] = exp2f(-(float)(wc * 32 + 8 * fq + 4 * n + j) * (13.287712379549449f / 127.0f)) * 0.15915494309189535f;
#pragma unroll
            for (int ai = 0; ai < 2; ++ai) {
#pragma unroll
                for (int m = 0; m < 4; ++m) {
                    const int row = row0 + ai * 128 + m * 16; const float rs = rsv[ai][m] * ksc; const float fp = (float)(row & (SEQ - 1));
                    bf16_t* rowp = Z + (size_t)row * NIN + col0;
                    f32x4 o0[2], o1[2];
#pragma unroll
                    for (int n = 0; n < 2; ++n) { f32x4 cs, sn;
#pragma unroll
                        for (int j = 0; j < 4; ++j) { float sa, ca; hw_sincos_rev(fp * ci[n][j], sa, ca); sn[j] = sa; cs[j] = ca; }
                        const f32x4 x1 = acc[ai][0][m][n] * rs, x2 = acc[ai][1][m][n] * rs; o0[n] = x1 * cs - x2 * sn; o1[n] = x2 * cs + x1 * sn; }
                    u32x4 w; w.x = cvt_pk_bf16(o0[0][0], o0[0][1]); w.y = cvt_pk_bf16(o0[0][2], o0[0][3]); w.z = cvt_pk_bf16(o0[1][0], o0[1][1]); w.w = cvt_pk_bf16(o0[1][2], o0[1][3]);
                    *(u32x4*)(rowp) = w;
                    w.x = cvt_pk_bf16(o1[0][0], o1[0][1]); w.y = cvt_pk_bf16(o1[0][2], o1[0][3]); w.z = cvt_pk_bf16(o1[1][0], o1[1][1]); w.w = cvt_pk_bf16(o1[1][2], o1[1][3]);
                    *(u32x4*)(rowp + 128) = w;
                }
            }
            return;
        }
#pragma unroll
        for (int ai = 0; ai < 2; ++ai)
#pragma unroll
            for (int m = 0; m < 4; ++m) {
                const int row = row0 + ai * 128 + m * 16;
                const float rs = rsv[ai][m];
                f32x4 v[2][2];
#pragma unroll
                for (int bj = 0; bj < 2; ++bj)
#pragma unroll
                    for (int n = 0; n < 2; ++n) v[bj][n] = acc[ai][bj][m][n] * rs;
                if (mode == 2) {
#pragma unroll
                    for (int bj = 0; bj < 2; ++bj)
#pragma unroll
                        for (int n = 0; n < 2; ++n)
#pragma unroll
                            for (int j = 0; j < 4; ++j) v[bj][n][j] = silu_f(v[bj][n][j]);
                } else if (mode == 3) {
#pragma unroll
                    for (int bj = 0; bj < 2; ++bj)
#pragma unroll
                        for (int n = 0; n < 2; ++n)
#pragma unroll
                            for (int j = 0; j < 4; ++j) v[bj][n][j] = sigm_f(v[bj][n][j]);
                }
                bf16_t* rowp = Z + (size_t)row * NIN + col0;
#pragma unroll
                for (int bj = 0; bj < 2; ++bj) {
                    u32x4 w; w.x = cvt_pk_bf16(v[bj][0][0], v[bj][0][1]); w.y = cvt_pk_bf16(v[bj][0][2], v[bj][0][3]); w.z = cvt_pk_bf16(v[bj][1][0], v[bj][1][1]); w.w = cvt_pk_bf16(v[bj][1][2], v[bj][1][3]);
                    *(u32x4*)(rowp + bj * 128) = w;
                }
            }
    }
};

struct MergeP {
    static constexpr bool PERM = true;
    const bf16_t *Y0, *W0; const bf16_t* Z; bf16_t* Mg; int G, c;
    __device__ __forceinline__ bool next(int i, pg8::Unit& u) const {
        const int ti = i / 3; u.sub = i - ti * 3;
        if (!pg8::tile_order((long)ti * G + c, T_TOK / 256, DM / 256, u.pm, u.pn)) return false;
        const bf16_t* yy = Y0 + (size_t)u.sub * (SZ_Y / 2); const bf16_t* ww = W0 + (size_t)u.sub * (DEPTH * SZ_WBR / 2);
        u.a = (const char*)(yy + (size_t)u.pm * 256 * 1024); u.b = (const char*)(ww + (size_t)u.pn * 256 * 1024); return true;
    }
    __device__ __forceinline__ bool keep(const pg8::Unit& u) const { return u.sub < 2; }
    __device__ __forceinline__ void epi(f32x4 (&acc)[2][2][4][2], const pg8::Unit& u, int wr, int wc, int fr, int fq) const {
        const int row0 = u.pm * 256 + wr * 64 + fr, col0 = u.pn * 256 + wc * 32 + 8 * fq;
        const int sub = u.sub;
        u32x4 gn[4][2][2], gd[4][2][2];
        const int dsub = sub < 2 ? sub + 1 : sub;
#define MG_LOAD(q) do { _Pragma("unroll") for (int mm = 0; mm < 2; ++mm) _Pragma("unroll") for (int bj = 0; bj < 2; ++bj) { \
            const bf16_t* gp = Z + (size_t)(row0 + ((q) >> 1) * 128 + (((q) & 1) * 2 + mm) * 16) * NIN + C_MG + col0 + bj * 128; \
            gn[q][mm][bj] = *(const u32x4*)(gp + sub * DM); if (sub < 2) gd[q][mm][bj] = *(const u32x4*)(gp + dsub * DM); else gd[q][mm][bj] = (u32x4){0u, 0u, 0u, 0u}; } } while (0)
#define MG_APPLY(q) do { _Pragma("unroll") for (int mm = 0; mm < 2; ++mm) _Pragma("unroll") for (int bj = 0; bj < 2; ++bj) { \
            const int ai = (q) >> 1, m = ((q) & 1) * 2 + mm; const u32x4 a4 = gn[q][mm][bj], d4 = gd[q][mm][bj]; \
            f32x4 f0 = (f32x4){lo16(a4[0]), hi16(a4[0]), lo16(a4[1]), hi16(a4[1])}, f1 = (f32x4){lo16(a4[2]), hi16(a4[2]), lo16(a4[3]), hi16(a4[3])}; \
            if (sub < 2) { \
                f0[0] *= __builtin_amdgcn_rcpf(lo16(d4[0])); f0[1] *= __builtin_amdgcn_rcpf(hi16(d4[0])); f0[2] *= __builtin_amdgcn_rcpf(lo16(d4[1])); f0[3] *= __builtin_amdgcn_rcpf(hi16(d4[1])); \
                f1[0] *= __builtin_amdgcn_rcpf(lo16(d4[2])); f1[1] *= __builtin_amdgcn_rcpf(hi16(d4[2])); f1[2] *= __builtin_amdgcn_rcpf(lo16(d4[3])); f1[3] *= __builtin_amdgcn_rcpf(hi16(d4[3])); } \
            acc[ai][bj][m][0] *= f0; acc[ai][bj][m][1] *= f1; \
            if (sub == 2) { const f32x4 v0 = acc[ai][bj][m][0], v1 = acc[ai][bj][m][1]; \
                u32x4 w; w.x = cvt_pk_bf16(v0[0], v0[1]); w.y = cvt_pk_bf16(v0[2], v0[3]); w.z = cvt_pk_bf16(v1[0], v1[1]); w.w = cvt_pk_bf16(v1[2], v1[3]); \
                *(u32x4*)(Mg + (size_t)(row0 + ai * 128 + m * 16) * DM + col0 + bj * 128) = w; } } } while (0)
        MG_LOAD(0); MG_LOAD(1);
        MG_APPLY(0); MG_LOAD(2);
        MG_APPLY(1); MG_LOAD(3);
        MG_APPLY(2); MG_APPLY(3);
#undef MG_LOAD
#undef MG_APPLY
    }
};

struct OutProj {
    static constexpr bool PERM = false;
    const bf16_t* A; const bf16_t* Bt; const float* xin; float* xout; bf16_t* xb; float* rowss_next; int G, c;
    __device__ __forceinline__ bool next(int i, pg8::Unit& u) const {
        if (!pg8::tile_order((long)i * G + c, T_TOK / 256, DM / 256, u.pm, u.pn)) return false;
        u.a = (const char*)(A + (size_t)u.pm * 256 * DM); u.b = (const char*)(Bt + (size_t)u.pn * 256 * DM); u.sub = 0; return true;
    }
    __device__ __forceinline__ bool keep(const pg8::Unit&) const { return false; }
    __device__ __forceinline__ void epi(f32x4 (&acc)[2][2][4][2], const pg8::Unit& u, int wr, int wc, int fr, int fq) const {
        const int row0 = u.pm * 256 + wr * 64 + fr, col0 = u.pn * 256 + wc * 32 + 4 * fq;
#pragma unroll
        for (int ai = 0; ai < 2; ++ai) {
            f32x4 xo[4][2][2];
#pragma unroll
            for (int m = 0; m < 4; ++m)
#pragma unroll
                for (int bj = 0; bj < 2; ++bj)
#pragma unroll
                    for (int n = 0; n < 2; ++n) xo[m][bj][n] = *(const f32x4*)(xin + (size_t)(row0 + ai * 128 + m * 16) * DM + col0 + bj * 128 + n * 16);
#pragma unroll
            for (int m = 0; m < 4; ++m) {
                const int row = row0 + ai * 128 + m * 16;
                const size_t off = (size_t)row * DM + col0;
                float ss = 0.f;
#pragma unroll
                for (int bj = 0; bj < 2; ++bj)
#pragma unroll
                    for (int n = 0; n < 2; ++n) {
                        const f32x4 o = xo[m][bj][n] + acc[ai][bj][m][n];
                        *(f32x4*)(xout + off + bj * 128 + n * 16) = o;
                        ss += o[0] * o[0] + o[1] * o[1] + o[2] * o[2] + o[3] * o[3];
                        if (rowss_next) { u32x2 w; w.x = cvt_pk_bf16(o[0], o[1]); w.y = cvt_pk_bf16(o[2], o[3]); *(u32x2*)(xb + off + bj * 128 + n * 16) = w; }
                    }
                if (rowss_next) {
                    ss += __shfl_xor(ss, 16); ss += __shfl_xor(ss, 32);
                    if (fq == 0) rowss_next[(size_t)row * 32 + u.pn * 4 + wc] = ss;
                }
            }
        }
    }
};

__device__ void tconv(const float* __restrict__ src, bf16_t* __restrict__ dst, int R, int C, const float* __restrict__ scale, float* tile) {
    const int tid = otid();
    const int ntc = C / 256, nt = (R / 64) * ntc;
    for (int t = blockIdx.x; t < nt; t += gridDim.x) {
        const int tr = t / ntc, tc = t - tr * ntc;
        {
            const int c4 = (tid & 63) * 4, r0 = tid >> 6;
            float4 v[8];
#pragma unroll
            for (int i = 0; i < 8; ++i) v[i] = *(const float4*)(src + (size_t)(tr * 64 + r0 + 8 * i) * C + tc * 256 + c4);
#pragma unroll
            for (int i = 0; i < 8; ++i) { const float sc = scale ? scale[tr * 64 + r0 + 8 * i] : 1.f; float* tp = tile + (r0 + 8 * i) * 257 + c4;
                tp[0] = v[i].x * sc; tp[1] = v[i].y * sc; tp[2] = v[i].z * sc; tp[3] = v[i].w * sc; }
        }
        __syncthreads();
#pragma unroll
        for (int i = 0; i < 4; ++i) {
            const int c = tid + 512 * i, kc = c & 7, n = c >> 3;
            const float* tp = tile + (kc * 8) * 257 + n;
            u32x4 o; o.x = cvt_pk_bf16(tp[0], tp[257]); o.y = cvt_pk_bf16(tp[514], tp[771]); o.z = cvt_pk_bf16(tp[1028], tp[1285]); o.w = cvt_pk_bf16(tp[1542], tp[1799]);
            *(u32x4*)(dst + (size_t)(tc * 256 + n) * R + tr * 64 + kc * 8) = o;
        }
        __syncthreads();
    }
}

__device__ void prologue(const Args& a, float* lds) {
    unsigned char* ws = a.ws;
    const int tid = otid(), lane = tid & 63, wave = tid >> 6;
    const size_t gtid = (size_t)blockIdx.x * NTHR + tid, gstr = (size_t)gridDim.x * NTHR;
    {
        const float* x = a.in[0]; bf16_t* xb = (bf16_t*)(ws + WS_XB); float* rowss = (float*)(ws + WS_ROWSS);
        for (int row = blockIdx.x * 8 + wave; row < T_TOK; row += gridDim.x * 8) {
            const float4* xp = (const float4*)(x + (size_t)row * DM); float ss = 0.f;
#pragma unroll
            for (int i = 0; i < 8; ++i) { const float4 v = xp[lane + 64 * i]; ss += v.x * v.x + v.y * v.y + v.z * v.z + v.w * v.w;
                u32x2 o; o.x = cvt_pk_bf16(v.x, v.y); o.y = cvt_pk_bf16(v.z, v.w); *(u32x2*)(xb + (size_t)row * DM + (lane + 64 * i) * 4) = o; }
            ss = wave_sum(ss);
            if (lane < 32) rowss[(size_t)row * 32 + lane] = lane == 0 ? ss : 0.f;
        }
    }
    if (blockIdx.x == 0) { if (tid < 64) ((unsigned*)(ws + WS_CTR))[tid] = 0u; for (int i = tid; i < 4096; i += NTHR) ((unsigned*)(ws + WS_BAR))[i] = 0u; }
#if !FAST_MIX
    {
        float* cR = (float*)(ws + WS_COSR); float* sR = (float*)(ws + WS_SINR); float* cA = (float*)(ws + WS_COSA); float* sA = (float*)(ws + WS_SINA);
        for (size_t i = gtid; i < (size_t)SEQ * 128; i += gstr) { const int s = (int)(i >> 7), k = (int)(i & 127);
            const float inv = 1.0f / exp2f((float)k * (1.0f / 127.0f) * 13.287712379549449f); float sn, cs; sincos_red((float)s * inv, sn, cs); cR[i] = cs; sR[i] = sn; }
        for (size_t i = gtid; i < (size_t)SEQ * 16; i += gstr) { const int s = (int)(i >> 4), k = (int)(i & 15);
            const float inv = exp2f(-(float)k * (1.0f / 16.0f) * 18.931568569324174f); float sn, cs; sincos_red((float)s * inv, sn, cs); cA[i] = cs; sA[i] = sn; }
    }
#endif
    for (int l = 0; l < DEPTH; ++l) {
        tconv(a.in[2] + (size_t)l * DM * NIN, (bf16_t*)(ws + WS_WIN + l * SZ_WIN), DM, NIN, a.in[1] + l * DM, lds);
        tconv(a.in[10] + (size_t)l * 1024 * DM, (bf16_t*)(ws + WS_WRET + l * SZ_WBR), 1024, DM, nullptr, lds);
        tconv(a.in[11] + (size_t)l * 1024 * DM, (bf16_t*)(ws + WS_WPOOL + l * SZ_WBR), 1024, DM, nullptr, lds);
        tconv(a.in[12] + (size_t)l * 1024 * DM, (bf16_t*)(ws + WS_WATT + l * SZ_WBR), 1024, DM, nullptr, lds);
        tconv(a.in[13] + (size_t)l * DM * DM, (bf16_t*)(ws + WS_WOUT + l * SZ_WOUT), DM, DM, nullptr, lds);
        for (int g = 0; g < 4; ++g) tconv(a.in[5] + ((size_t)l * 4 + g) * 65536, (bf16_t*)(ws + WS_PW + l * SZ_PW) + g * 65536, 256, 256, nullptr, lds);
    }
}

__device__ void ret_scan_naive(const Args& a, int l) {
    const bf16_t* Z = (const bf16_t*)(a.ws + WS_Z);
    const size_t gtid = (size_t)blockIdx.x * NTHR + otid(), gstr = (size_t)gridDim.x * NTHR;
    for (size_t idx = gtid; idx < (size_t)2097152; idx += gstr) {
        const int d = (int)(idx & 255), e = (int)((idx >> 8) & 255), dir = (int)((idx >> 16) & 1), bh = (int)(idx >> 17), b = bh >> 2, h = bh & 3;
        const float lg = -expf(a.in[dir ? 4 : 3][l * 4 + h]);
        const float dec = expf(lg * 128.f);
        bf16_t* ST = (bf16_t*)(a.ws + (dir ? WS_SB : WS_SF));
        float st = 0.f;
        for (int step = 0; step < 32; ++step) {
            const int n = dir ? 31 - step : step;
            ST[(((size_t)bh * 32 + n) * 256 + e) * 256 + d] = f2bf(st);
            float kv = 0.f;
            const bf16_t* zp = Z + (size_t)(b * SEQ + n * 128) * NIN + h * 256;
            for (int j = 0; j < 128; ++j) {
                const float w = dir ? expf(lg * (float)j) : expf(lg * (float)(127 - j));
                kv += bf2f(zp[(size_t)j * NIN + C_RK + d]) * w * bf2f(zp[(size_t)j * NIN + C_RV + e]);
            }
            st = st * dec + kv;
        }
    }
}

__device__ void ret_out_naive(const Args& a, int l, float* P) {
    const bf16_t* Z = (const bf16_t*)(a.ws + WS_Z); bf16_t* Ya = (bf16_t*)(a.ws + WS_YA);
    const bf16_t* SF = (const bf16_t*)(a.ws + WS_SF); const bf16_t* SB = (const bf16_t*)(a.ws + WS_SB);
    const int tid = otid();
    for (int item = blockIdx.x; item < 512; item += gridDim.x) {
        const int b = item >> 7, n = (item >> 2) & 31, h = item & 3, bh = b * 4 + h;
        const int t0 = b * SEQ + n * 128;
        const float lgf = -expf(a.in[3][l * 4 + h]), lgb = -expf(a.in[4][l * 4 + h]);
        for (int p = tid; p < 16384; p += NTHR) {
            const int j = p >> 7, k = p & 127;
            const bf16_t* qp = Z + (size_t)(t0 + j) * NIN + C_RQ + h * 256; const bf16_t* kp = Z + (size_t)(t0 + k) * NIN + C_RK + h * 256;
            float dot = 0.f;
            for (int d = 0; d < 256; ++d) dot += bf2f(qp[d]) * bf2f(kp[d]);
            const int lag = j - k;
            P[p] = dot * (lag >= 0 ? expf(lgf * (float)lag) : expf(lgb * (float)(-lag)));
        }
        __syncthreads();
        for (int pass = 0; pass < 4; ++pass) {
            const int j = pass * 32 + (tid >> 4), eg = tid & 15;
            float o[16];
#pragma unroll
            for (int i = 0; i < 16; ++i) o[i] = 0.f;
            for (int k = 0; k < 128; ++k) {
                const float pv = P[j * 128 + k];
                const bf16_t* vp = Z + (size_t)(t0 + k) * NIN + C_RV + h * 256 + eg * 16;
#pragma unroll
                for (int i = 0; i < 16; ++i) o[i] += pv * bf2f(vp[i]);
            }
            const bf16_t* qp = Z + (size_t)(t0 + j) * NIN + C_RQ + h * 256;
            const float qf = expf(lgf * (float)(j + 1)), qb = expf(lgb * (float)(128 - j));
#pragma unroll
            for (int i = 0; i < 16; ++i) {
                const size_t so = (((size_t)bh * 32 + n) * 256 + eg * 16 + i) * 256;
                float cf = 0.f, cb = 0.f;
                for (int d = 0; d < 256; ++d) { const float qv = bf2f(qp[d]); cf += qv * bf2f(SF[so + d]); cb += qv * bf2f(SB[so + d]); }
                o[i] += qf * cf + qb * cb;
            }
            float ss = 0.f;
#pragma unroll
            for (int i = 0; i < 16; ++i) ss += o[i] * o[i];
            ss += __shfl_xor(ss, 1); ss += __shfl_xor(ss, 2); ss += __shfl_xor(ss, 4); ss += __shfl_xor(ss, 8);
            const float rs = rsqrtf(ss * (1.0f / 256.0f) + 1e-6f);
            const bf16_t* gp = Z + (size_t)(t0 + j) * NIN + C_RG + h * 256 + eg * 16;
            bf16_t* yp = Ya + (size_t)(t0 + j) * 1024 + h * 256 + eg * 16;
#pragma unroll
            for (int i = 0; i < 16; ++i) yp[i] = f2bf(o[i] * rs * bf2f(gp[i]));
        }
        __syncthreads();
    }
}

__device__ void attn_naive(const Args& a, int l, float* lds) {
    const bf16_t* Z = (const bf16_t*)(a.ws + WS_Z); bf16_t* Yc = (bf16_t*)(a.ws + WS_YC);
    const float* cA = (const float*)(a.ws + WS_COSA); const float* sA = (const float*)(a.ws + WS_SINA);
    const float* qg = a.in[7] + l * 128; const float* kg = a.in[8] + l * 128; const float* sink = a.in[9] + l * 8;
    float* qs = lds; float* ps = lds + 8 * 128;
    const int tid = otid(), lane = tid & 63, wave = tid >> 6;
    for (int w0 = blockIdx.x * 8; w0 < T_TOK * 8; w0 += gridDim.x * 8) {
        const int qi = w0 + wave, t = qi >> 3, hq = qi & 7, kvh = hq >> 2, pos = t & (SEQ - 1), b = t >> 12;
        const bf16_t* qp = Z + (size_t)t * NIN + C_AQ + hq * 128;
        {
            const float x0 = bf2f(qp[lane]), x1 = bf2f(qp[lane + 64]);
            const float ss = wave_sum(x0 * x0 + x1 * x1); const float rs = rsqrtf(ss * (1.0f / 128.0f) + 1e-6f);
            qs[wave * 128 + lane] = x0 * rs * qg[lane]; qs[wave * 128 + lane + 64] = x1 * rs * qg[lane + 64];
        }
        __syncthreads();
        float rot = 0.f;
        if (lane < 32) { const int i = lane & 15; const float xa = qs[wave * 128 + i], xb = qs[wave * 128 + i + 16], c = cA[pos * 16 + i], s = sA[pos * 16 + i]; rot = lane < 16 ? xa * c - xb * s : xb * c + xa * s; }
        __syncthreads();
        if (lane < 32) qs[wave * 128 + lane] = rot;
        __syncthreads();
        float sc[5]; const float skv = sink[hq]; float mx = skv;
#pragma unroll
        for (int r = 0; r < 5; ++r) {
            const int jrel = lane + 64 * r, kp = pos - 128 + jrel; const bool valid = (jrel <= 256) && (kp >= 0) && (kp < SEQ);
            float s = -1e30f;
            if (valid) {
                const bf16_t* kr = Z + (size_t)(b * SEQ + kp) * NIN + C_AK + kvh * 128;
                float kss = 0.f;
                for (int d = 0; d < 128; ++d) { const float kv = bf2f(kr[d]); kss += kv * kv; }
                const float rsk = rsqrtf(kss * (1.0f / 128.0f) + 1e-6f);
                float dot = 0.f;
                for (int i = 0; i < 16; ++i) { const float xa = bf2f(kr[i]) * kg[i], xb = bf2f(kr[i + 16]) * kg[i + 16], c = cA[kp * 16 + i], sn = sA[kp * 16 + i];
                    dot += (xa * c - xb * sn) * qs[wave * 128 + i] + (xb * c + xa * sn) * qs[wave * 128 + i + 16]; }
                for (int d = 32; d < 128; ++d) dot += bf2f(kr[d]) * kg[d] * qs[wave * 128 + d];
                s = dot * rsk * 0.08838834764831845f;
            }
            sc[r] = s; mx = fmaxf(mx, s);
        }
        mx = wave_max(mx);
        float sum = 0.f;
#pragma unroll
        for (int r = 0; r < 5; ++r) { const float p = __expf(sc[r] - mx); sc[r] = p; sum += p; }
        sum = wave_sum(sum) + __expf(skv - mx);
        const float isum = 1.0f / sum;
#pragma unroll
        for (int r = 0; r < 5; ++r) ps[wave * 320 + lane + 64 * r] = sc[r] * isum;
        __syncthreads();
        float o0 = 0.f, o1 = 0.f;
        for (int jrel = 0; jrel <= 256; ++jrel) { const int kp = pos - 128 + jrel; if (kp < 0 || kp >= SEQ) continue;
            const float p = ps[wave * 320 + jrel]; const bf16_t* vr = Z + (size_t)(b * SEQ + kp) * NIN + C_AV + kvh * 128; o0 += p * bf2f(vr[lane]); o1 += p * bf2f(vr[lane + 64]); }
        const bf16_t* gp = Z + (size_t)t * NIN + C_AG + hq * 128; bf16_t* yp = Yc + (size_t)t * 1024 + hq * 128;
        yp[lane] = f2bf(o0 * bf2f(gp[lane])); yp[lane + 64] = f2bf(o1 * bf2f(gp[lane + 64]));
        __syncthreads();
    }
}

__device__ void pool_naive(const Args& a, int l, float* P) {
    const bf16_t* Z = (const bf16_t*)(a.ws + WS_Z); bf16_t* Yb = (bf16_t*)(a.ws + WS_YB);
    const float* pw = a.in[5] + (size_t)l * 4 * 65536; const float* psc = a.in[6] + l * 1024;
    const int tid = otid();
    for (int tile = blockIdx.x; tile < T_TOK / 16; tile += gridDim.x) {
        const int t0 = tile * 16;
        for (int p = tid; p < 16 * 1024; p += NTHR) {
            const int tt = p >> 10, c = p & 1023, g = c >> 8, hw = 1 << g;
            const int t = t0 + tt, pos = t & (SEQ - 1), bb = t - pos;
            int lo = pos - hw, hi = pos + hw; lo = lo < 0 ? 0 : lo; hi = hi > SEQ ? SEQ : hi;
            float s = 0.f;
            for (int q = lo; q < hi; ++q) s += bf2f(Z[(size_t)(bb + q) * NIN + C_PV + c]);
            P[p] = s / (float)(hi - lo) - bf2f(Z[(size_t)t * NIN + C_PV + c]);
        }
        __syncthreads();
        for (int p = tid; p < 16 * 1024; p += NTHR) {
            const int tt = p >> 10, c = p & 1023, g = c >> 8, e = c & 255;
            const float* pp = P + tt * 1024 + g * 256; const float* wp = pw + (size_t)g * 65536 + e;
            float acc = 0.f;
            for (int d = 0; d < 256; ++d) acc += pp[d] * wp[(size_t)d * 256];
            const int t = t0 + tt;
            Yb[(size_t)t * 1024 + c] = f2bf(acc * psc[c] * bf2f(Z[(size_t)t * NIN + C_PG + c]));
        }
        __syncthreads();
    }
}


typedef short bf16x4 __attribute__((ext_vector_type(4)));
__device__ __forceinline__ f32x4 mfma16(bf16x8 a, bf16x8 b, f32x4 c) { return __builtin_amdgcn_mfma_f32_16x16x32_bf16(a, b, c, 0, 0, 0); }
__device__ __forceinline__ bf16x4 trr(LAS unsigned char* p) { return __builtin_amdgcn_ds_read_tr16_b64_v4i16((LAS bf16x4*)p); }
__device__ __forceinline__ bf16x8 cat8(bf16x4 a, bf16x4 b) { return __builtin_shufflevector(a, b, 0, 1, 2, 3, 4, 5, 6, 7); }
__device__ __forceinline__ bf16x8 pack8(f32x4 a, f32x4 b) { u32x4 w; w.x = cvt_pk_bf16(a[0], a[1]); w.y = cvt_pk_bf16(a[2], a[3]); w.z = cvt_pk_bf16(b[0], b[1]); w.w = cvt_pk_bf16(b[2], b[3]); return __builtin_bit_cast(bf16x8, w); }

__device__ __forceinline__ void pool_item(const Args& a, int l, int it, LAS unsigned char* lds, int tid) {
    const bf16_t* Z = (const bf16_t*)(a.ws + WS_Z); bf16_t* Yb = (bf16_t*)(a.ws + WS_YB);
    const bf16_t* PWt = (const bf16_t*)(a.ws + WS_PW + (size_t)l * SZ_PW); const float* psc = a.in[6] + l * 1024;
    const int lane = tid & 63, wave = tid >> 6, g = it & 3, tile = it >> 2, t0 = tile * 128, hw = 1 << g;
    LAS unsigned char* Us = lds; LAS unsigned char* Ps = lds + 144 * 528;
    {
        const int pos0 = t0 & (SEQ - 1);
#pragma unroll
        for (int i = 0; i < 9; ++i) { const int c = tid + 512 * i, row = c >> 5, ch = c & 31, pos = pos0 - 8 + row;
            int tr = t0 - 8 + row; tr = tr < 0 ? 0 : (tr >= T_TOK ? T_TOK - 1 : tr);
            u32x4 v = *(const u32x4*)(Z + (size_t)tr * NIN + C_PV + g * 256 + ch * 8);
            const unsigned keep = (pos >= 0 && pos < SEQ) ? 0xffffffffu : 0u; v.x &= keep; v.y &= keep; v.z &= keep; v.w &= keep;
            *(LAS u32x4*)(Us + row * 528 + ch * 16) = v; }
    }
    __syncthreads();
    {
        const int c8 = (tid & 31) * 8, rg = tid >> 5, r0 = rg * 8, pos0 = (t0 & (SEQ - 1)) + r0;
        LAS unsigned char* ub = Us + (r0 + 8) * 528 + c8 * 2;
        f32x4 sa = (f32x4){0.f, 0.f, 0.f, 0.f}, sb = (f32x4){0.f, 0.f, 0.f, 0.f};
        for (int j = -hw; j < hw; ++j) { const u32x4 v = *(const LAS u32x4*)(ub + j * 528);
            sa += (f32x4){lo16(v.x), hi16(v.x), lo16(v.y), hi16(v.y)}; sb += (f32x4){lo16(v.z), hi16(v.z), lo16(v.w), hi16(v.w)}; }
#pragma unroll 1
        for (int i = 0; i < 8; ++i) {
            const int pos = pos0 + i; int lo = pos - hw, hi = pos + hw; lo = lo < 0 ? 0 : lo; hi = hi > SEQ ? SEQ : hi;
            const float ic = 1.0f / (float)(hi - lo);
            const u32x4 cv = *(const LAS u32x4*)(ub + i * 528), vin = *(const LAS u32x4*)(ub + (i + hw) * 528), vout = *(const LAS u32x4*)(ub + (i - hw) * 528);
            const f32x4 ca = (f32x4){lo16(cv.x), hi16(cv.x), lo16(cv.y), hi16(cv.y)}, cb = (f32x4){lo16(cv.z), hi16(cv.z), lo16(cv.w), hi16(cv.w)};
            *(LAS bf16x8*)(Ps + (r0 + i) * 528 + c8 * 2) = pack8(sa * ic - ca, sb * ic - cb);
            sa += (f32x4){lo16(vin.x), hi16(vin.x), lo16(vin.y), hi16(vin.y)} - (f32x4){lo16(vout.x), hi16(vout.x), lo16(vout.y), hi16(vout.y)};
            sb += (f32x4){lo16(vin.z), hi16(vin.z), lo16(vin.w), hi16(vin.w)} - (f32x4){lo16(vout.z), hi16(vout.z), lo16(vout.w), hi16(vout.w)};
        }
    }
    __syncthreads();
    const int wr = wave >> 2, wc = wave & 3, fr = lane & 15, fq = lane >> 4;
    f32x4 acc[4][4];
#pragma unroll
    for (int i = 0; i < 4; ++i)
#pragma unroll
        for (int j = 0; j < 4; ++j) acc[i][j] = (f32x4){0.f, 0.f, 0.f, 0.f};
    const bf16_t* Bp = PWt + (size_t)g * 65536 + (size_t)(wc * 64 + fr) * 256 + 8 * fq;
#pragma unroll 1
    for (int kh = 0; kh < 2; ++kh) {
        bf16x8 bfr[4][4];
#pragma unroll
        for (int k4 = 0; k4 < 4; ++k4)
#pragma unroll
            for (int nt = 0; nt < 4; ++nt) bfr[k4][nt] = *(const bf16x8*)(Bp + nt * 16 * 256 + (kh * 4 + k4) * 32);
#pragma unroll
        for (int k4 = 0; k4 < 4; ++k4) {
            bf16x8 af[4];
#pragma unroll
            for (int mt = 0; mt < 4; ++mt) af[mt] = *(const LAS bf16x8*)(Ps + (wr * 64 + mt * 16 + fr) * 528 + ((kh * 4 + k4) * 32 + 8 * fq) * 2);
#pragma unroll
            for (int mt = 0; mt < 4; ++mt)
#pragma unroll
                for (int nt = 0; nt < 4; ++nt) acc[mt][nt] = mfma16(bfr[k4][nt], af[mt], acc[mt][nt]);
        }
    }
    {
        u32x2 gt[4][4]; f32x4 scv[4];
#pragma unroll
        for (int nt = 0; nt < 4; ++nt) scv[nt] = *(const f32x4*)(psc + g * 256 + wc * 64 + nt * 16 + 4 * fq);
#pragma unroll
        for (int mt = 0; mt < 4; ++mt)
#pragma unroll
            for (int nt = 0; nt < 4; ++nt) gt[mt][nt] = *(const u32x2*)(Z + (size_t)(t0 + wr * 64 + mt * 16 + fr) * NIN + C_PG + g * 256 + wc * 64 + nt * 16 + 4 * fq);
#pragma unroll
        for (int mt = 0; mt < 4; ++mt) {
            const int t = t0 + wr * 64 + mt * 16 + fr;
#pragma unroll
            for (int nt = 0; nt < 4; ++nt) {
                const int c = g * 256 + wc * 64 + nt * 16 + 4 * fq;
                const f32x4 v = acc[mt][nt] * scv[nt]; const u32x2 gg = gt[mt][nt];
                u32x2 o; o.x = cvt_pk_bf16(v[0] * lo16(gg.x), v[1] * hi16(gg.x)); o.y = cvt_pk_bf16(v[2] * lo16(gg.y), v[3] * hi16(gg.y));
                *(u32x2*)(Yb + (size_t)t * 1024 + c) = o;
            }
        }
    }
}

#define ATT_CI(i) ((i) == 0 ? 1.591549431e-01f : (i) == 1 ? 7.008652159e-02f : (i) == 2 ? 3.086376340e-02f : (i) == 3 ? 1.359137064e-02f : (i) == 4 ? 5.985185713e-03f : (i) == 5 ? 2.635675899e-03f : \
    (i) == 6 ? 1.160663641e-03f : (i) == 7 ? 5.111175045e-04f : (i) == 8 ? 2.250790790e-04f : (i) == 9 ? 9.911730937e-05f : (i) == 10 ? 4.364795279e-05f : (i) == 11 ? 1.922110068e-05f : \
    (i) == 12 ? 8.464330808e-06f : (i) == 13 ? 3.727408602e-06f : (i) == 14 ? 1.641426263e-06f : 7.228293069e-07f)

__device__ __forceinline__ void attn_item(const Args& a, int l, int it, LAS unsigned char* lds, int tid) {
    const bf16_t* Z = (const bf16_t*)(a.ws + WS_Z); bf16_t* Yc = (bf16_t*)(a.ws + WS_YC);
    const float* cA = (const float*)(a.ws + WS_COSA); const float* sA = (const float*)(a.ws + WS_SINA);
    const float* qg = a.in[7] + l * 128; const float* kg = a.in[8] + l * 128; const float* sink = a.in[9] + l * 8;
    const int lane = tid & 63, wave = tid >> 6, fr = lane & 15, fq = lane >> 4;
    const int half = it & 1, kvh = (it >> 1) & 1, n = (it >> 2) & 31, b = it >> 7;
    const int hq = kvh * 4 + half * 2 + (wave >> 2), qrow0 = (wave & 3) * 32, tq0 = b * SEQ + n * 128;
    LAS unsigned char* Ks = lds; LAS unsigned char* Vs = lds + 128 * 272;
    LAS unsigned char* Qs = lds + 71680 + (wave * 32 + fr) * 272 + 16 * fq;
#pragma unroll
    for (int qt = 0; qt < 2; ++qt) {
        const int qrow = qrow0 + qt * 16 + fr, pos = n * 128 + qrow;
        const bf16_t* qp = Z + (size_t)(tq0 + qrow) * NIN + C_AQ + hq * 128 + 8 * fq;
        f32x4 x[4][2]; float ss = 0.f;
#pragma unroll
        for (int ks = 0; ks < 4; ++ks) { const u32x4 r = *(const u32x4*)(qp + ks * 32);
            x[ks][0] = (f32x4){lo16(r.x), hi16(r.x), lo16(r.y), hi16(r.y)}; x[ks][1] = (f32x4){lo16(r.z), hi16(r.z), lo16(r.w), hi16(r.w)};
            const f32x4 q0 = x[ks][0] * x[ks][0], q1 = x[ks][1] * x[ks][1]; ss += (q0[0] + q0[1]) + (q0[2] + q0[3]) + (q1[0] + q1[1]) + (q1[2] + q1[3]); }
        ss += __shfl_xor(ss, 16); ss += __shfl_xor(ss, 32);
        const float rs = rsqrtf(ss * (1.0f / 128.0f) + 1e-6f) * 0.08838834764831845f;
#pragma unroll
        for (int ks = 0; ks < 4; ++ks) { x[ks][0] *= *(const f32x4*)(qg + ks * 32 + 8 * fq) * rs; x[ks][1] *= *(const f32x4*)(qg + ks * 32 + 8 * fq + 4) * rs; }
        {
            f32x4 c0, c1, s0, s1; const float fp = (float)pos; const bool hi8 = (fq & 1) != 0;
#pragma unroll
            for (int j = 0; j < 4; ++j) { float sa, ca, sb, cb; hw_sincos_rev(fp * (hi8 ? ATT_CI(8 + j) : ATT_CI(j)), sa, ca); hw_sincos_rev(fp * (hi8 ? ATT_CI(12 + j) : ATT_CI(4 + j)), sb, cb); s0[j] = sa; c0[j] = ca; s1[j] = sb; c1[j] = cb; }
            f32x4 p0, p1;
#pragma unroll
            for (int j = 0; j < 4; ++j) { p0[j] = __shfl_xor(x[0][0][j], 32); p1[j] = __shfl_xor(x[0][1][j], 32); }
            const float sg = fq < 2 ? -1.f : 1.f;
            x[0][0] = x[0][0] * c0 + p0 * s0 * sg; x[0][1] = x[0][1] * c1 + p1 * s1 * sg;
        }
#pragma unroll
        for (int ks = 0; ks < 4; ++ks) *(LAS bf16x8*)(Qs + qt * 16 * 272 + ks * 64) = pack8(x[ks][0], x[ks][1]);
    }
    float mrun[2], lsum[2]; f32x4 O[8][2];
    { const float sk = sink[hq]; mrun[0] = sk; mrun[1] = sk; lsum[0] = fq == 0 ? 1.f : 0.f; lsum[1] = lsum[0]; }
#pragma unroll
    for (int dt = 0; dt < 8; ++dt) { O[dt][0] = (f32x4){0.f, 0.f, 0.f, 0.f}; O[dt][1] = (f32x4){0.f, 0.f, 0.f, 0.f}; }
#pragma unroll 1
    for (int j = 0; j < 3; ++j) {
        const int kb = n - 1 + j; if (kb < 0 || kb > 31) continue;
        {
            const int key = tid >> 2, qtr = tid & 3, kpos = kb * 128 + key;
            const bf16_t* kp = Z + (size_t)(b * SEQ + kpos) * NIN + C_AK + kvh * 128 + qtr * 32;
            u32x4 kr[4], vr[4];
#pragma unroll
            for (int i = 0; i < 4; ++i) { kr[i] = *(const u32x4*)(kp + i * 8); vr[i] = *(const u32x4*)(kp + (C_AV - C_AK) + i * 8); }
            f32x4 x[8]; float ss = 0.f;
#pragma unroll
            for (int i = 0; i < 4; ++i) { const u32x4 r = kr[i];
                x[2 * i] = (f32x4){lo16(r.x), hi16(r.x), lo16(r.y), hi16(r.y)}; x[2 * i + 1] = (f32x4){lo16(r.z), hi16(r.z), lo16(r.w), hi16(r.w)};
                const f32x4 q0 = x[2 * i] * x[2 * i], q1 = x[2 * i + 1] * x[2 * i + 1]; ss += (q0[0] + q0[1]) + (q0[2] + q0[3]) + (q1[0] + q1[1]) + (q1[2] + q1[3]); }
            ss += __shfl_xor(ss, 1); ss += __shfl_xor(ss, 2);
            const float rs = rsqrtf(ss * (1.0f / 128.0f) + 1e-6f);
#pragma unroll
            for (int i = 0; i < 8; ++i) x[i] *= *(const f32x4*)(kg + qtr * 32 + 4 * i) * rs;
            if (qtr == 0) {
                const float fp = (float)kpos;
#pragma unroll
                for (int i = 0; i < 4; ++i) { f32x4 c, sn;
#pragma unroll
                    for (int jj = 0; jj < 4; ++jj) { float sa, ca; hw_sincos_rev(fp * ATT_CI(4 * i + jj), sa, ca); sn[jj] = sa; c[jj] = ca; }
                    const f32x4 xa = x[i], xb = x[i + 4]; x[i] = xa * c - xb * sn; x[i + 4] = xb * c + xa * sn; }
            }
#pragma unroll
            for (int i = 0; i < 4; ++i) *(LAS bf16x8*)(Ks + key * 272 + qtr * 64 + i * 16) = pack8(x[2 * i], x[2 * i + 1]);
#pragma unroll
            for (int i = 0; i < 4; ++i) *(LAS u32x4*)(Vs + key * 288 + qtr * 64 + i * 16) = vr[i];
        }
        __syncthreads();
        const int msg = (j == 0) ? 1 : ((j == 2) ? -1 : 0);
        f32x4 S[8][2];
        {
            bf16x8 qfr[2][4];
#pragma unroll
            for (int qt = 0; qt < 2; ++qt)
#pragma unroll
                for (int ks = 0; ks < 4; ++ks) qfr[qt][ks] = *(const LAS bf16x8*)(Qs + qt * 16 * 272 + ks * 64);
#pragma unroll
            for (int kt = 0; kt < 8; ++kt) {
                bf16x8 kf[4];
#pragma unroll
                for (int ks = 0; ks < 4; ++ks) kf[ks] = *(const LAS bf16x8*)(Ks + (kt * 16 + fr) * 272 + (ks * 32 + 8 * fq) * 2);
#pragma unroll
                for (int qt = 0; qt < 2; ++qt) { f32x4 sacc = (f32x4){0.f, 0.f, 0.f, 0.f};
#pragma unroll
                    for (int ks = 0; ks < 4; ++ks) sacc = mfma16(kf[ks], qfr[qt][ks], sacc);
                    S[kt][qt] = sacc; }
            }
        }
#pragma unroll
        for (int qt = 0; qt < 2; ++qt) {
            const int ql = qrow0 + qt * 16 + fr; float mx = mrun[qt];
            int dbase = msg * (4 * fq - ql); asm volatile("" : "+v"(dbase), "+v"(S[7][1]));
#pragma unroll
            for (int kt = 0; kt < 8; ++kt)
#pragma unroll
                for (int r = 0; r < 4; ++r) { const int dd = dbase + msg * (kt * 16 + r); const float pen = (float)min(dd, 0) * 1e30f;
                    const float sv = S[kt][qt][r] + pen; S[kt][qt][r] = sv; mx = fmaxf(mx, sv); }
            mx = fmaxf(mx, __shfl_xor(mx, 16)); mx = fmaxf(mx, __shfl_xor(mx, 32));
            const float alpha = __expf(mrun[qt] - mx); mrun[qt] = mx; float ls = lsum[qt] * alpha;
#pragma unroll
            for (int kt = 0; kt < 8; ++kt)
#pragma unroll
                for (int r = 0; r < 4; ++r) { const float p = __expf(S[kt][qt][r] - mx); S[kt][qt][r] = p; ls += p; }
            lsum[qt] = ls;
#pragma unroll
            for (int dt = 0; dt < 8; ++dt) O[dt][qt] *= alpha;
        }
#pragma unroll
        for (int ks2 = 0; ks2 < 4; ++ks2) {
            bf16x8 pf[2];
#pragma unroll
            for (int qt = 0; qt < 2; ++qt) pf[qt] = pack8(S[2 * ks2][qt], S[2 * ks2 + 1][qt]);
#pragma unroll
            for (int dt = 0; dt < 8; ++dt) {
                LAS unsigned char* vb = Vs + (ks2 * 32 + 4 * fq + (fr >> 2)) * 288 + (dt * 16 + 4 * (lane & 3)) * 2;
                const bf16x8 vf = cat8(trr(vb), trr(vb + 16 * 288));
#pragma unroll
                for (int qt = 0; qt < 2; ++qt) O[dt][qt] = mfma16(vf, pf[qt], O[dt][qt]);
            }
        }
        __syncthreads();
    }
    {
        u32x2 gt[2][8];
#pragma unroll
        for (int qt = 0; qt < 2; ++qt)
#pragma unroll
            for (int dt = 0; dt < 8; ++dt) gt[qt][dt] = *(const u32x2*)(Z + (size_t)(tq0 + qrow0 + qt * 16 + fr) * NIN + C_AG + hq * 128 + dt * 16 + 4 * fq);
#pragma unroll
        for (int qt = 0; qt < 2; ++qt) {
            float ls = lsum[qt]; ls += __shfl_xor(ls, 16); ls += __shfl_xor(ls, 32);
            const float inv = 1.0f / ls; const int t = tq0 + qrow0 + qt * 16 + fr;
#pragma unroll
            for (int dt = 0; dt < 8; ++dt) {
                const int c = hq * 128 + dt * 16 + 4 * fq;
                const u32x2 gg = gt[qt][dt]; const f32x4 v = O[dt][qt] * inv;
                u32x2 o; o.x = cvt_pk_bf16(v[0] * lo16(gg.x), v[1] * hi16(gg.x)); o.y = cvt_pk_bf16(v[2] * lo16(gg.y), v[3] * hi16(gg.y));
                *(u32x2*)(Yc + (size_t)t * 1024 + c) = o;
            }
        }
    }
}

__device__ __forceinline__ void scan_item(const Args& a, int l, int it, LAS unsigned char* lds, int tid) {
    const bf16_t* Z = (const bf16_t*)(a.ws + WS_Z);
    const int lane = tid & 63, wave = tid >> 6, fr = lane & 15, fq = lane >> 4;
    const int dsl = it & 3, dir = (it >> 2) & 1, bh = it >> 3, b = bh >> 2, h = bh & 3;
    bf16_t* ST = (bf16_t*)(a.ws + (dir ? WS_SB : WS_SF)) + (size_t)bh * 32 * 65536;
    const float lg = -expf(a.in[dir ? 4 : 3][l * 4 + h]); const float dec = expf(lg * 128.f);
    LAS unsigned char* Ks = lds; LAS unsigned char* Vs = lds + 20480;
    f32x4 st[4][2];
#pragma unroll
    for (int dt = 0; dt < 4; ++dt) { st[dt][0] = (f32x4){0.f, 0.f, 0.f, 0.f}; st[dt][1] = (f32x4){0.f, 0.f, 0.f, 0.f}; }
    u32x4 vrA[8], krA[2], vrB[8], krB[2];
    const bf16_t* zb = Z + (size_t)(b * SEQ) * NIN + h * 256;
#define SCAN_LOAD(vreg, kreg, nn) do { const bf16_t* zc = zb + (size_t)((nn) * 128) * NIN; \
        _Pragma("unroll") for (int i = 0; i < 8; ++i) { const int c = tid + 512 * i; vreg[i] = *(const u32x4*)(zc + (size_t)(c >> 5) * NIN + C_RV + (c & 31) * 8); } \
        _Pragma("unroll") for (int i = 0; i < 2; ++i) { const int c = tid + 512 * i; kreg[i] = *(const u32x4*)(zc + (size_t)(c >> 3) * NIN + C_RK + dsl * 64 + (c & 7) * 8); } } while (0)
#define SCAN_STEP(vreg, kreg, step) do { \
        const int n = dir ? 31 - (step) : (step); \
        _Pragma("unroll") for (int i = 0; i < 8; ++i) { const int c = tid + 512 * i; *(LAS u32x4*)(Vs + (c >> 5) * 544 + (c & 31) * 16) = vreg[i]; } \
        _Pragma("unroll") for (int i = 0; i < 2; ++i) { const int c = tid + 512 * i, row = c >> 3; const float w = dir ? __expf(lg * (float)row) : __expf(lg * (float)(127 - row)); \
            const u32x4 r = kreg[i]; u32x4 o; o.x = cvt_pk_bf16(lo16(r.x) * w, hi16(r.x) * w); o.y = cvt_pk_bf16(lo16(r.y) * w, hi16(r.y) * w); o.z = cvt_pk_bf16(lo16(r.z) * w, hi16(r.z) * w); o.w = cvt_pk_bf16(lo16(r.w) * w, hi16(r.w) * w); \
            *(LAS u32x4*)(Ks + row * 160 + (c & 7) * 16) = o; } \
        __syncthreads(); \
        if ((step) + 2 < 32) SCAN_LOAD(vreg, kreg, dir ? 29 - (step) : (step) + 2); \
        bf16_t* so = ST + (size_t)n * 65536; \
        _Pragma("unroll") for (int dt = 0; dt < 4; ++dt) \
            _Pragma("unroll") for (int e2 = 0; e2 < 2; ++e2) { const int e = (2 * wave + e2) * 16 + fr, d = dsl * 64 + dt * 16 + 4 * fq; const f32x4 v = st[dt][e2]; \
                u32x2 o; o.x = cvt_pk_bf16(v[0], v[1]); o.y = cvt_pk_bf16(v[2], v[3]); *(u32x2*)(so + (size_t)e * 256 + d) = o; st[dt][e2] = v * dec; } \
        _Pragma("unroll") for (int ks2 = 0; ks2 < 4; ++ks2) { \
            const int krow = ks2 * 32 + 4 * fq + (fr >> 2); \
            bf16x8 af[4], bfr[2]; \
            _Pragma("unroll") for (int dt = 0; dt < 4; ++dt) { LAS unsigned char* p = Ks + krow * 160 + (dt * 16 + 4 * (lane & 3)) * 2; af[dt] = cat8(trr(p), trr(p + 16 * 160)); } \
            _Pragma("unroll") for (int e2 = 0; e2 < 2; ++e2) { LAS unsigned char* p = Vs + krow * 544 + ((2 * wave + e2) * 16 + 4 * (lane & 3)) * 2; bfr[e2] = cat8(trr(p), trr(p + 16 * 544)); } \
            _Pragma("unroll") for (int dt = 0; dt < 4; ++dt) \
                _Pragma("unroll") for (int e2 = 0; e2 < 2; ++e2) st[dt][e2] = mfma16(af[dt], bfr[e2], st[dt][e2]); } \
        __syncthreads(); } while (0)
    SCAN_LOAD(vrA, krA, dir ? 31 : 0);
    SCAN_LOAD(vrB, krB, dir ? 30 : 1);
#pragma unroll 1
    for (int step = 0; step < 32; step += 2) {
        SCAN_STEP(vrA, krA, step);
        SCAN_STEP(vrB, krB, step + 1);
    }
#undef SCAN_STEP
#undef SCAN_LOAD
}

__device__ __forceinline__ void rout_item(const Args& a, int l, int it, LAS unsigned char* lds, int tid) {
    const bf16_t* Z = (const bf16_t*)(a.ws + WS_Z); bf16_t* Ya = (bf16_t*)(a.ws + WS_YA);
    const int lane = tid & 63, wave = tid >> 6, fr = lane & 15, fq = lane >> 4;
    const int b = it >> 7, n = (it >> 2) & 31, h = it & 3, bh = b * 4 + h, t0 = b * SEQ + n * 128;
    const float lgf = -expf(a.in[3][l * 4 + h]), lgb = -expf(a.in[4][l * 4 + h]);
    LAS unsigned char* Ks = lds; LAS unsigned char* Vs = lds + 128 * 528;
#pragma unroll 1
    for (int i4 = 0; i4 < 2; ++i4) {
        u32x4 kr[4], vr[4];
#pragma unroll
        for (int i = 0; i < 4; ++i) { const int c = tid + 512 * (i4 * 4 + i), row = c >> 5, ch = c & 31; const bf16_t* zp = Z + (size_t)(t0 + row) * NIN + h * 256 + ch * 8;
            kr[i] = *(const u32x4*)(zp + C_RK); vr[i] = *(const u32x4*)(zp + C_RV); }
#pragma unroll
        for (int i = 0; i < 4; ++i) { const int c = tid + 512 * (i4 * 4 + i), row = c >> 5, ch = c & 31;
            *(LAS u32x4*)(Ks + row * 528 + ch * 16) = kr[i]; *(LAS u32x4*)(Vs + row * 544 + ch * 16) = vr[i]; }
    }
    const int jq = wave * 16 + fr;
    bf16x8 qf[8];
#pragma unroll
    for (int ks = 0; ks < 8; ++ks) qf[ks] = *(const bf16x8*)(Z + (size_t)(t0 + jq) * NIN + C_RQ + h * 256 + ks * 32 + 8 * fq);
    __syncthreads();
    f32x4 S[8];
#pragma unroll
    for (int kt = 0; kt < 8; ++kt) { f32x4 sacc = (f32x4){0.f, 0.f, 0.f, 0.f};
#pragma unroll
        for (int ks = 0; ks < 8; ++ks) sacc = mfma16(*(const LAS bf16x8*)(Ks + (kt * 16 + fr) * 528 + (ks * 32 + 8 * fq) * 2), qf[ks], sacc);
        S[kt] = sacc; }
    {
        int lb = jq - 4 * fq; asm volatile("" : "+v"(lb), "+v"(S[7]));
#pragma unroll
        for (int kt = 0; kt < 8; ++kt)
#pragma unroll
            for (int r = 0; r < 4; ++r) { const float fl = (float)(lb - (kt * 16 + r)); S[kt][r] *= __expf(fmaxf(fl, 0.f) * lgf + fmaxf(-fl, 0.f) * lgb); }
    }
    f32x4 O[16];
#pragma unroll
    for (int dt = 0; dt < 16; ++dt) O[dt] = (f32x4){0.f, 0.f, 0.f, 0.f};
#pragma unroll
    for (int ks2 = 0; ks2 < 4; ++ks2) {
        const bf16x8 pf = pack8(S[2 * ks2], S[2 * ks2 + 1]);
#pragma unroll
        for (int dt = 0; dt < 16; ++dt) { LAS unsigned char* vb = Vs + (ks2 * 32 + 4 * fq + (fr >> 2)) * 544 + (dt * 16 + 4 * (lane & 3)) * 2;
            O[dt] = mfma16(cat8(trr(vb), trr(vb + 16 * 544)), pf, O[dt]); if ((dt & 3) == 3) asm volatile("" ::: "memory"); }
    }
    bf16x8 qf2[8];
    { const bf16_t* qp2 = Z + (size_t)(t0 + jq) * NIN + C_RQ + h * 256 + 8 * fq; asm volatile("" : "+v"(qp2));
#pragma unroll
      for (int ks = 0; ks < 8; ++ks) qf2[ks] = *(const bf16x8*)(qp2 + ks * 32); }
    __syncthreads();
#pragma unroll 1
    for (int dir = 0; dir < 2; ++dir) {
        if ((dir == 0 && n == 0) || (dir == 1 && n == 31)) continue;
        const bf16_t* ST = (const bf16_t*)(a.ws + (dir ? WS_SB : WS_SF)) + ((size_t)bh * 32 + n) * 65536;
#pragma unroll 1
        for (int hh = 0; hh < 2; ++hh) {
            u32x4 sreg[8];
#pragma unroll
            for (int i = 0; i < 8; ++i) { const int c = tid + 512 * (i + 8 * hh); sreg[i] = *(const u32x4*)(ST + (size_t)(c >> 5) * 256 + (c & 31) * 8); }
#pragma unroll
            for (int i = 0; i < 8; ++i) { const int c = tid + 512 * (i + 8 * hh); *(LAS u32x4*)(lds + (c >> 5) * 528 + (c & 31) * 16) = sreg[i]; }
        }
        __syncthreads();
        const float sc = dir ? __expf(lgb * (float)(128 - jq)) : __expf(lgf * (float)(jq + 1));
#pragma unroll
        for (int dt = 0; dt < 16; ++dt) { f32x4 tacc = (f32x4){0.f, 0.f, 0.f, 0.f};
#pragma unroll
            for (int ks = 0; ks < 8; ++ks) tacc = mfma16(*(const LAS bf16x8*)(lds + (dt * 16 + fr) * 528 + (ks * 32 + 8 * fq) * 2), qf2[ks], tacc);
            O[dt] += tacc * sc; }
        __syncthreads();
    }
    float ss = 0.f;
#pragma unroll
    for (int dt = 0; dt < 16; ++dt) { const f32x4 q = O[dt] * O[dt]; ss += (q[0] + q[1]) + (q[2] + q[3]); }
    ss += __shfl_xor(ss, 16); ss += __shfl_xor(ss, 32);
    const float rs = rsqrtf(ss * (1.0f / 256.0f) + 1e-6f);
    {
        u32x2 gt[16];
#pragma unroll
        for (int dt = 0; dt < 16; ++dt) gt[dt] = *(const u32x2*)(Z + (size_t)(t0 + jq) * NIN + C_RG + h * 256 + dt * 16 + 4 * fq);
#pragma unroll
        for (int dt = 0; dt < 16; ++dt) { const int c = h * 256 + dt * 16 + 4 * fq; const u32x2 gg = gt[dt]; const f32x4 v = O[dt] * rs;
            u32x2 o; o.x = cvt_pk_bf16(v[0] * lo16(gg.x), v[1] * hi16(gg.x)); o.y = cvt_pk_bf16(v[2] * lo16(gg.y), v[3] * hi16(gg.y));
            *(u32x2*)(Ya + (size_t)(t0 + jq) * 1024 + c) = o; }
    }
}

__device__ __forceinline__ int next_item(unsigned* ctr, LAS int* slot, int tid) {
    __syncthreads();
    if (tid == 0) *slot = (int)atomicAdd(ctr, 1u);
    __syncthreads();
    return *slot;
}
__device__ void mix1_fast(const Args& a, int l, LAS unsigned char* lds, int cofs) {
    unsigned* ctr = (unsigned*)(a.ws + WS_CTR) + cofs + l * 4;
    LAS int* slot = (LAS int*)(lds + LDS_BYTES - 16);
#if PROBE_DUP & 256
    { const int tid = otid(); for (;;) { const int it = next_item(ctr, slot, tid); if (it >= 256) break; scan_item(a, l, it & 127, lds, tid); } }
#else
    { const int tid = otid(); for (;;) { const int it = next_item(ctr, slot, tid); if (it >= 128) break; scan_item(a, l, it, lds, tid); } }
#endif
#if PROBE_DUP & 512
    { const int tid = otid(); for (;;) { const int it = next_item(ctr + 1, slot, tid); if (it >= 1024) break; attn_item(a, l, it & 511, lds, tid); } }
#else
    { const int tid = otid(); for (;;) { const int it = next_item(ctr + 1, slot, tid); if (it >= 512) break; attn_item(a, l, it, lds, tid); } }
#endif
    { const int tid = otid(); for (;;) { const int it = next_item(ctr + 2, slot, tid); if (it >= 512) break; pool_item(a, l, it, lds, tid); } }
}
__device__ void rout_fast(const Args& a, int l, LAS unsigned char* lds, int cofs) {
    const int tid = otid();
    unsigned* ctr = (unsigned*)(a.ws + WS_CTR) + cofs + l * 4 + 3;
    LAS int* slot = (LAS int*)(lds + LDS_BYTES - 16);
    for (;;) {
        const int it = next_item(ctr, slot, tid);
        if (it >= 512) break;
        rout_item(a, l, it, lds, tid);
    }
}


#define XB_TMO      128
#define XB_XCNT(j)  (256  + 64 * (j))
#define XB_XSUB(j)  (1280 + 64 * (j))
#define XB_XGEN(j)  (2304 + 64 * (j))
#define XB_TOP      3328
#define XB_TOPGEN   3392
#define XCD_BAR_WORDS 3456
#define XB_SPIN_CAP (1u << 18)
__device__ __forceinline__ unsigned xb_ld(unsigned* p)              { return __hip_atomic_load(p, __ATOMIC_RELAXED, __HIP_MEMORY_SCOPE_AGENT); }
__device__ __forceinline__ unsigned xb_add(unsigned* p, unsigned v) { return __hip_atomic_fetch_add(p, v, __ATOMIC_RELAXED, __HIP_MEMORY_SCOPE_AGENT); }
__device__ __forceinline__ unsigned xb_xcc_id() { return (unsigned)__builtin_amdgcn_s_getreg((3 << 11) | 20) & 0xFu; }
#define XB_SPIN(cond, bar) do { unsigned _sp = 0; while (cond) { __builtin_amdgcn_s_sleep(1); \
    if ((++_sp & 255u) == 0u) { if (xb_ld(&(bar)[XB_TMO])) break; if (_sp > XB_SPIN_CAP) { atomicAdd(&(bar)[XB_TMO], 1u); break; } } } } while (0)
struct XcdBarrier { unsigned* bar; unsigned x; volatile LAS unsigned* st; };
__device__ __forceinline__ XcdBarrier xcd_barrier_post(unsigned* bar, volatile LAS unsigned* st) {
    XcdBarrier b; b.bar = bar; b.x = xb_xcc_id(); b.st = st;
    if (threadIdx.x == 0) (void)xb_add(&bar[XB_XCNT(b.x)], 1u);
    return b;
}
__device__ __forceinline__ void xcd_barrier_complete(unsigned* bar, unsigned x, unsigned& nloc, unsigned& nx) {
    const unsigned G = gridDim.x * gridDim.y * gridDim.z;
    unsigned sum, cnt, mine, sp = 0u;
    for (;;) {
        sum = 0u; cnt = 0u; mine = 0u;
#pragma unroll
        for (unsigned j = 0; j < 16; ++j) { const unsigned c = xb_ld(&bar[XB_XCNT(j)]); sum += c; cnt += (c > 0u) ? 1u : 0u; mine = (j == x) ? c : mine; }
        if (sum == G) break;
        __builtin_amdgcn_s_sleep(1);
        if ((++sp & 255u) == 0u) { if (xb_ld(&bar[XB_TMO])) break; if (sp > XB_SPIN_CAP) { atomicAdd(&bar[XB_TMO], 1u); break; } }
    }
    nloc = mine > 0u ? mine : 1u; nx = cnt > 0u ? cnt : 1u;
}
__device__ __forceinline__ void xcd_barrier(const XcdBarrier& b) {
    asm volatile("s_waitcnt vmcnt(0)" ::: "memory");
    __syncthreads();
    if (threadIdx.x == 0) {
        unsigned* bar = b.bar;
        __builtin_amdgcn_s_waitcnt(0);
        unsigned nloc = b.st[0], nx = b.st[1];
        if (nloc == 0u) { xcd_barrier_complete(bar, b.x, nloc, nx); b.st[0] = nloc; b.st[1] = nx; }
        const unsigned old = xb_add(&bar[XB_XSUB(b.x)], 1u);
        const unsigned gen = old / nloc;
        if (old + 1u == (gen + 1u) * nloc) {
            __builtin_amdgcn_fence(__ATOMIC_RELEASE, "agent");
            asm volatile("s_waitcnt vmcnt(0)" ::: "memory");
            const unsigned og = xb_add(&bar[XB_TOP], 1u);
            const unsigned tg = og / nx;
            if (og + 1u == (tg + 1u) * nx) xb_add(&bar[XB_TOPGEN], 1u);
            else XB_SPIN(xb_ld(&bar[XB_TOPGEN]) == tg, bar);
            __builtin_amdgcn_fence(__ATOMIC_ACQUIRE, "agent");
            xb_add(&bar[XB_XGEN(b.x)], 1u);
            asm volatile("s_waitcnt vmcnt(0)" ::: "memory");
        } else {
            XB_SPIN(xb_ld(&bar[XB_XGEN(b.x)]) == gen, bar);
            __builtin_amdgcn_fence(__ATOMIC_ACQUIRE, "agent");
            asm volatile("s_waitcnt vmcnt(0)" ::: "memory");
        }
    }
    __syncthreads();
}

constexpr int N_PHASES = 1 + 5 * DEPTH;

__global__ void __launch_bounds__(NTHR, 2) mk_fwd(Args a) {
    extern __shared__ __attribute__((aligned(16))) unsigned char lds_raw[];
    LAS unsigned char* lds = (LAS unsigned char*)lds_raw;
    float* ldsf = (float*)lds_raw;
    unsigned char* ws = a.ws;
    const int lo = a.ph_lo, hi = a.ph_hi;
#ifndef PHMASK
#define PHMASK 0xff
#endif
#define IN(k) (lo <= (k) && (k) < hi)
    volatile LAS unsigned* xst = (volatile LAS unsigned*)(lds + LDS_BYTES - 32);
    if (threadIdx.x < 2) xst[threadIdx.x] = 0u;
    __syncthreads();
#define SEAM(k) do { if (IN(k) && IN((k) + 1)) { if ((k) == 0) { cg::this_grid().sync(); (void)xcd_barrier_post((unsigned*)(a.ws + WS_BAR), xst); } else { XcdBarrier xb_; xb_.bar = (unsigned*)(a.ws + WS_BAR); xb_.x = xb_xcc_id(); xb_.st = xst; xcd_barrier(xb_); } } } while (0)
    if ((PHMASK & 1) && IN(0)) { prologue(a, ldsf);
#if PROBE_DUP & 1
        prologue(a, ldsf);
#endif
    }
    SEAM(0);
    for (int l = 0; l < DEPTH; ++l) {
        const int pb = 1 + 5 * l;
        if ((PHMASK & 2) && IN(pb)) {
            int pm0, pn0_; pg8::tile_order((long)blockIdx.x, T_TOK / 256, NIN / 256, pm0, pn0_);
            LAS float* rsl = (LAS float*)(lds + 131072);
            {
                const int t = otid();
                if (t < 256) { const f32x4* rp = (const f32x4*)((const float*)(ws + WS_ROWSS) + (size_t)(pm0 * 256 + t) * 32);
                    f32x4 p[8];
#pragma unroll
                    for (int q = 0; q < 8; ++q) p[q] = rp[q];
                    float sk[4];
#pragma unroll
                    for (int q = 0; q < 4; ++q) { const f32x4 t4 = p[2 * q] + p[2 * q + 1]; sk[q] = (t4[0] + t4[1]) + (t4[2] + t4[3]); }
                    rsl[t] = rsqrtf(((sk[0] + sk[1]) + (sk[2] + sk[3])) * (1.0f / DM) + 1e-6f); }
                __syncthreads();
            }
            InProj S{(const bf16_t*)(ws + WS_XB), (const bf16_t*)(ws + WS_WIN + l * SZ_WIN), (bf16_t*)(ws + WS_Z), (const float*)(ws + WS_ROWSS),
                     (const float*)(ws + WS_COSR), (const float*)(ws + WS_SINR), (int)gridDim.x, (int)blockIdx.x, pm0, rsl};
            pg8::gemm_phase<InProj>(lds, DM, S);
#if PROBE_DUP & 8
            pg8::gemm_phase<InProj>(lds, DM, S);
#endif
        }
        SEAM(pb);
        if (IN(pb + 1)) {
#if FAST_MIX
            if (PHMASK & 4) mix1_fast(a, l, lds, 0);
#if PROBE_DUP & 2
            mix1_fast(a, l, lds, 32);
#endif
#else
            if (PHMASK & 4) ret_scan_naive(a, l);
            if (PHMASK & 8) attn_naive(a, l, ldsf);
            if (PHMASK & 16) pool_naive(a, l, ldsf);
#endif
        }
        SEAM(pb + 1);
        #if FAST_ROUT
        if ((PHMASK & 32) && IN(pb + 2)) { rout_fast(a, l, lds, 0);
#if PROBE_DUP & 4
            rout_fast(a, l, lds, 32);
#endif
        }
#else
        if ((PHMASK & 32) && IN(pb + 2)) { ret_out_naive(a, l, ldsf); }
#endif
        SEAM(pb + 2);
        if ((PHMASK & 64) && IN(pb + 3)) {
            MergeP S{(const bf16_t*)(ws + WS_YA), (const bf16_t*)(ws + WS_WRET + l * SZ_WBR),
                     (const bf16_t*)(ws + WS_Z), (bf16_t*)(ws + WS_MG), (int)gridDim.x, (int)blockIdx.x};
            pg8::gemm_phase<MergeP>(lds, 1024, S);
#if PROBE_DUP & 16
            pg8::gemm_phase<MergeP>(lds, 1024, S);
#endif
        }
        SEAM(pb + 3);
        if ((PHMASK & 128) && IN(pb + 4)) {
            OutProj S{(const bf16_t*)(ws + WS_MG), (const bf16_t*)(ws + WS_WOUT + l * SZ_WOUT), l == 0 ? a.in[0] : a.out, a.out, (bf16_t*)(ws + WS_XB),
                      l + 1 < DEPTH ? (float*)(ws + WS_ROWSS) : nullptr, (int)gridDim.x, (int)blockIdx.x};
            pg8::gemm_phase<OutProj>(lds, DM, S);
#if PROBE_DUP & 64
            if (l == 0) { pg8::gemm_phase<OutProj>(lds, DM, S); pg8::gemm_phase<OutProj>(lds, DM, S); }
#endif
        }
        SEAM(pb + 4);
    }
#undef IN
#undef SEAM
}

extern "C" void kernel_launch(void* const* d_in, const int* in_sizes, int n_in, void* d_out, int out_size, void* d_ws, size_t ws_size, hipStream_t stream) {
    static int grid = 0;
    if (grid == 0) {
        if (n_in != 14 || out_size != T_TOK * DM || ws_size < WS_END) { fprintf(stderr, "kernel_launch: unexpected shapes (n_in %d out %d ws %zu need %zu)\n", n_in, out_size, ws_size, (size_t)WS_END); grid = -1; return; }
        int dev = 0, cus = 0, per_cu = 0;
        hipGetDevice(&dev); hipDeviceGetAttribute(&cus, hipDeviceAttributeMultiprocessorCount, dev);
        if (hipFuncSetAttribute((const void*)mk_fwd, hipFuncAttributeMaxDynamicSharedMemorySize, LDS_BYTES) != hipSuccess) { fprintf(stderr, "kernel_launch: hipFuncSetAttribute failed\n"); grid = -1; return; }
        if (hipOccupancyMaxActiveBlocksPerMultiprocessor(&per_cu, (const void*)mk_fwd, NTHR, LDS_BYTES) != hipSuccess || per_cu < 1) { fprintf(stderr, "kernel_launch: occupancy query says %d\n", per_cu); per_cu = 1; }
        (void)hipGetLastError();
        grid = cus * 1;
    }
    if (grid < 0) return;
    Args a{};
    for (int i = 0; i < 14; ++i) a.in[i] = (const float*)d_in[i];
    a.out = (float*)d_out; a.ws = (unsigned char*)d_ws;
#if ONE_LAUNCH
    a.ph_lo = 0; a.ph_hi = N_PHASES;
    void* args[] = {&a};
    hipError_t e = hipLaunchCooperativeKernel((const void*)mk_fwd, dim3(grid), dim3(NTHR), args, LDS_BYTES, stream);
    if (e != hipSuccess) fprintf(stderr, "cooperative launch failed: %s (grid %d)\n", hipGetErrorString(e), grid);
#else
    for (int p = 0; p < N_PHASES; ++p) {
        a.ph_lo = p; a.ph_hi = p + 1;
        hipLaunchKernelGGL(mk_fwd, dim3(grid), dim3(NTHR), LDS_BYTES, stream, a);
    }
#endif
}
```
